# Optimizing an MI355X kernel written in HIP

```python
import jax, jax.numpy as jnp
from jax import lax
import numpy as np

D_MODEL = 1024
BATCH = 8
SEQ = 4096
DEPTH = 1

HEAD_DIM = 64
N_HEADS_A = 8
DILATED_PATTERNS = ((128, 1), (512, 4), (2048, 16))
N_HEADS_B = 8
Q_LORA_RANK = 256
KV_LORA_RANK = 128
QK_NOPE_DIM = 64
QK_ROPE_DIM = 32
V_HEAD_DIM = 64
ROPE_THETA = 10000.0
Q_BLOCK = 128
N_BUCKETS = 32
MAX_DISTANCE = 1024
D_FF = 4 * D_MODEL
NORM_EPS = 1e-6
NEG_INF = -1e30

WIDTH_A = N_HEADS_A * HEAD_DIM
WIDTH_B = N_HEADS_B * V_HEAD_DIM
MIX_WIDTH = WIDTH_A + WIDTH_B
IN_SPLITS = (WIDTH_A, WIDTH_A, WIDTH_A, Q_LORA_RANK, KV_LORA_RANK, QK_ROPE_DIM)
IN_COLS = sum(IN_SPLITS)

kernel_name = "hybrid_dilated_mla_encoder_block"


def rms_norm(x, g):
    xf = x.astype(jnp.float32)
    y = xf * lax.rsqrt(jnp.mean(xf * xf, axis=-1, keepdims=True) + NORM_EPS)
    return (y * g.astype(jnp.float32)).astype(x.dtype)


def t5_buckets(rel):
    nb = N_BUCKETS // 2
    max_exact = nb // 2
    ret = (rel > 0).astype(np.int32) * nb
    n = np.abs(rel)
    large = max_exact + (np.log(np.maximum(n, 1) / max_exact)
                         / np.log(MAX_DISTANCE / max_exact) * (nb - max_exact)).astype(np.int32)
    large = np.minimum(large, nb - 1)
    return (ret + np.where(n < max_exact, n, large)).astype(np.int32)


def dilated_window_pattern(q, k, v, rel_bias, window, dilation):
    B, S, H, Dh = q.shape
    radius = window // (2 * dilation)
    blk = radius
    L = S // dilation
    nblk = -(-L // blk)
    pad = nblk * blk - L
    scale = HEAD_DIM ** -0.5

    def strided(t):
        return t.reshape(B, L, dilation, H, Dh).transpose(0, 3, 2, 1, 4)

    qb = jnp.pad(strided(q), ((0, 0), (0, 0), (0, 0), (0, pad), (0, 0)))
    qb = qb.reshape(B, H, dilation, nblk, blk, Dh)

    def key_windows(t):
        t = jnp.pad(strided(t), ((0, 0), (0, 0), (0, 0), (blk, pad + blk), (0, 0)))
        t = t.reshape(B, H, dilation, nblk + 2, blk, Dh)
        return jnp.concatenate([t[:, :, :, :-2], t[:, :, :, 1:-1], t[:, :, :, 2:]], axis=4)

    kw = key_windows(k)
    vw = key_windows(v)

    qi = np.arange(blk)[:, None]
    ki = np.arange(3 * blk)[None, :]
    rel = ki - blk - qi
    kidx = np.arange(nblk)[:, None, None] * blk - blk + ki[None]
    valid = (np.abs(rel) <= radius)[None] & (kidx >= 0) & (kidx < L)
    bias = rel_bias[jnp.asarray(t5_buckets(rel * dilation))]
    bias = jnp.transpose(bias, (2, 0, 1)).astype(jnp.float32)[:, None, None]

    s = jnp.einsum('bhrnqd,bhrnkd->bhrnqk', qb, kw).astype(jnp.float32) * scale + bias
    s = jnp.where(jnp.asarray(valid)[None, None, None], s, NEG_INF)
    m = jnp.max(s, axis=-1, keepdims=True)
    p = jnp.exp(s - m)
    den = jnp.sum(p, axis=-1, keepdims=True)
    num = jnp.einsum('bhrnqk,bhrnkd->bhrnqd', p, vw.astype(jnp.float32))

    def unstride(t):
        c = t.shape[-1]
        t = t.reshape(B, H, dilation, nblk * blk, c)[:, :, :, :L]
        return t.transpose(0, 3, 2, 1, 4).reshape(B, S, H, c)

    return unstride(num), unstride(m), unstride(den)


def dilated_attention(q, k, v, rel_bias):
    parts = [dilated_window_pattern(q, k, v, rel_bias, w, d) for (w, d) in DILATED_PATTERNS]
    m_all = parts[0][1]
    for _, m_i, _ in parts[1:]:
        m_all = jnp.maximum(m_all, m_i)
    num = 0.0
    den = 0.0
    for num_i, m_i, den_i in parts:
        w_i = jnp.exp(m_i - m_all)
        num = num + w_i * num_i
        den = den + w_i * den_i
    return (num / den).astype(q.dtype)


def rope_tables(S):
    inv_freq = ROPE_THETA ** (-jnp.arange(0, QK_ROPE_DIM, 2, dtype=jnp.float32) / QK_ROPE_DIM)
    pos = jnp.arange(S, dtype=jnp.float32)
    freqs = pos[:, None] * inv_freq[None, :]
    return jnp.cos(freqs), jnp.sin(freqs)


def apply_rope(t, cos, sin):
    tf = t.astype(jnp.float32)
    half = tf.shape[-1] // 2
    t1, t2 = tf[..., :half], tf[..., half:]
    return jnp.concatenate([t1 * cos - t2 * sin, t2 * cos + t1 * sin], axis=-1).astype(t.dtype)


def latent_attention(c_q, c_kv, k_rope, q_norm_g, w_q_b, kv_norm_g, w_kv_b, cos, sin):
    B, S, _ = c_q.shape
    H = N_HEADS_B
    dqk = QK_NOPE_DIM + QK_ROPE_DIM
    q = (rms_norm(c_q, q_norm_g) @ w_q_b).reshape(B, S, H, dqk)
    q_nope, q_pe = q[..., :QK_NOPE_DIM], q[..., QK_NOPE_DIM:]
    q_pe = apply_rope(q_pe, cos[:, None, :], sin[:, None, :])
    kv = (rms_norm(c_kv, kv_norm_g) @ w_kv_b).reshape(B, S, H, QK_NOPE_DIM + V_HEAD_DIM)
    k_nope, v = kv[..., :QK_NOPE_DIM], kv[..., QK_NOPE_DIM:]
    k_pe = apply_rope(k_rope, cos, sin)
    k = jnp.concatenate([k_nope, jnp.broadcast_to(k_pe[:, :, None, :], (B, S, H, QK_ROPE_DIM))], axis=-1)
    q = jnp.concatenate([q_nope, q_pe], axis=-1)

    scale = dqk ** -0.5
    qb = q.reshape(B, S // Q_BLOCK, Q_BLOCK, H, dqk).transpose(1, 0, 3, 2, 4)
    kh = k.transpose(0, 2, 1, 3)
    vh = v.transpose(0, 2, 1, 3).astype(jnp.float32)

    def attend(q_blk):
        s = jnp.einsum('bhqd,bhkd->bhqk', q_blk, kh).astype(jnp.float32) * scale
        p = jax.nn.softmax(s, axis=-1)
        return jnp.einsum('bhqk,bhkd->bhqd', p, vh).astype(v.dtype)

    o = lax.map(attend, qb)
    return o.transpose(1, 0, 3, 2, 4).reshape(B, S, H * V_HEAD_DIM)


def setup_inputs(seed: int = 0) -> dict:
    key = jax.random.key(seed)
    ks = jax.random.split(key, 16)
    f32 = jnp.float32

    def nrm(k, shape, fan_in):
        return jax.random.normal(k, shape, f32) * (fan_in ** -0.5)

    def gain(k, shape):
        return 1.0 + 0.02 * jax.random.normal(k, shape, f32)

    return {
        "x": jax.random.normal(ks[0], (BATCH, SEQ, D_MODEL), f32),
        "mix_norm_g": gain(ks[1], (DEPTH, D_MODEL)),
        "w_in": nrm(ks[2], (DEPTH, D_MODEL, IN_COLS), D_MODEL),
        "q_norm_g": gain(ks[3], (DEPTH, Q_LORA_RANK)),
        "w_q_b": nrm(ks[4], (DEPTH, Q_LORA_RANK, N_HEADS_B * (QK_NOPE_DIM + QK_ROPE_DIM)), Q_LORA_RANK),
        "kv_norm_g": gain(ks[5], (DEPTH, KV_LORA_RANK)),
        "w_kv_b": nrm(ks[6], (DEPTH, KV_LORA_RANK, N_HEADS_B * (QK_NOPE_DIM + V_HEAD_DIM)), KV_LORA_RANK),
        "w_out": nrm(ks[7], (DEPTH, MIX_WIDTH, D_MODEL), MIX_WIDTH),
        "mlp_norm_g": gain(ks[8], (DEPTH, D_MODEL)),
        "w_up": nrm(ks[9], (DEPTH, D_MODEL, D_FF), D_MODEL),
        "w_down": nrm(ks[10], (DEPTH, D_FF, D_MODEL), D_FF),
        "rel_bias": 0.5 * jax.random.normal(ks[11], (N_BUCKETS, N_HEADS_A), f32),
        "final_norm_g": gain(ks[12], (D_MODEL,)),
    }


def reference(x, mix_norm_g, w_in, q_norm_g, w_q_b, kv_norm_g, w_kv_b, w_out,
              mlp_norm_g, w_up, w_down, rel_bias, final_norm_g):
    B, S, _ = x.shape
    cos, sin = rope_tables(S)
    split_at = [int(v) for v in np.cumsum(IN_SPLITS)[:-1]]
    h = x
    for layer in range(DEPTH):
        u = rms_norm(h, mix_norm_g[layer])
        proj = u @ w_in[layer]
        q_a, k_a, v_a, c_q, c_kv, k_rope = jnp.split(proj, split_at, axis=-1)
        o_a = dilated_attention(q_a.reshape(B, S, N_HEADS_A, HEAD_DIM),
                                k_a.reshape(B, S, N_HEADS_A, HEAD_DIM),
                                v_a.reshape(B, S, N_HEADS_A, HEAD_DIM),
                                rel_bias).reshape(B, S, WIDTH_A)
        o_b = latent_attention(c_q, c_kv, k_rope, q_norm_g[layer], w_q_b[layer],
                               kv_norm_g[layer], w_kv_b[layer], cos, sin)
        h = h + jnp.concatenate([o_a, o_b], axis=-1) @ w_out[layer]
        u = rms_norm(h, mlp_norm_g[layer])
        h = h + jnp.square(jax.nn.relu(u @ w_up[layer])) @ w_down[layer]
    return rms_norm(h, final_norm_g)
```

```cpp
#include <hip/hip_runtime.h>
#include <cstdint>
#include <cstdio>

typedef unsigned short bf16_t;

constexpr int BATCH = 8, SEQ = 4096, DM = 1024, MTOK = BATCH * SEQ;
constexpr int NPROJ = 2048;
constexpr int NPROJ_REAL = 1952;
constexpr int COL_QA = 0, COL_KA = 512, COL_VA = 1024, COL_CQ = 1536, COL_CKV = 1792, COL_KR = 1920;
constexpr int NQB = 768, NKVB = 1024, DFF = 4096;
constexpr float EPS = 1e-6f;
constexpr float LOG2E = 1.4426950408889634f;
constexpr float QSCALE_A = 0.125f * LOG2E;
constexpr float QSCALE_B = 0.10206207261596575f * LOG2E;

constexpr size_t MiB = 1u << 20;
constexpr size_t WS_CTL = 0, CTL_BYTES = 1 * MiB;
constexpr size_t WS_SSQ_Q = 0, WS_SSQ_KV = 128 * 1024, WS_SSQ_H1 = 256 * 1024, WS_SSQ_H2 = 384 * 1024;
constexpr size_t WS_ROPE = 1 * MiB;
constexpr size_t WS_XBUF = 1 * MiB + 512 * 1024;
constexpr size_t WS_WIN = 2 * MiB, WS_WQB = 6 * MiB, WS_WKVB = 7 * MiB, WS_WOUT = 8 * MiB, WS_WUP = 10 * MiB, WS_WDOWN = 18 * MiB;
constexpr size_t WS_XN = 32 * MiB, WS_O = 404 * MiB, WS_XRS = 468 * MiB;
constexpr size_t WS_PROJ = 96 * MiB, WS_QB = 224 * MiB, WS_KVB = 272 * MiB, WS_KPE = 336 * MiB, WS_H1B = 340 * MiB;
constexpr size_t WS_ACT = 32 * MiB;
constexpr size_t WS_END = 469 * MiB;

__device__ __forceinline__ unsigned f2bf(float f) { unsigned u = __builtin_bit_cast(unsigned, f); return (u + 0x7fffu + ((u >> 16) & 1u)) >> 16; }
__device__ __forceinline__ float bf2f(bf16_t h) { return __builtin_bit_cast(float, (unsigned)h << 16); }
__device__ __forceinline__ float wave_sum(float v) {
#pragma unroll
    for (int o = 1; o < 64; o <<= 1) v += __shfl_xor(v, o);
    return v;
}
__device__ __forceinline__ float wave_max(float v) {
#pragma unroll
    for (int o = 1; o < 64; o <<= 1) v = fmaxf(v, __shfl_xor(v, o));
    return v;
}
__device__ __forceinline__ int t5_bucket(int rel) {
    const int n = rel < 0 ? -rel : rel;
    int b;
    if (n < 8) b = n;
    else b = 8 + (n >= 15) + (n >= 27) + (n >= 50) + (n >= 91) + (n >= 166) + (n >= 305) + (n >= 559);
    return b + (rel > 0 ? 16 : 0);
}


#include <hip/hip_cooperative_groups.h>
namespace cg = cooperative_groups;
#define LAS __attribute__((address_space(3)))
typedef short bf16x8 __attribute__((ext_vector_type(8)));
typedef short s16x4 __attribute__((ext_vector_type(4)));
typedef float f32x4 __attribute__((ext_vector_type(4)));
typedef float f32x16 __attribute__((ext_vector_type(16)));
typedef unsigned u32x4 __attribute__((ext_vector_type(4)));
typedef unsigned u32x2 __attribute__((ext_vector_type(2)));
typedef float f32x2_t __attribute__((ext_vector_type(2)));
typedef __bf16 bf16x2_t __attribute__((ext_vector_type(2)));
__device__ __forceinline__ unsigned cvtpk(float lo, float hi) { f32x2_t v = {lo, hi}; bf16x2_t b = __builtin_convertvector(v, bf16x2_t); return __builtin_bit_cast(unsigned, b); }
__device__ __forceinline__ s16x4 tr16(const LAS unsigned char* p) { typedef short v4i16_t __attribute__((ext_vector_type(4))); return __builtin_bit_cast(s16x4, __builtin_amdgcn_ds_read_tr16_b64_v4i16((LAS v4i16_t*)p)); }

constexpr int NWAVES = 8, NTHREADS = 512;
__device__ __forceinline__ int fresh_tid() { int t = threadIdx.x; asm volatile("" : "+v"(t)); return t; }
constexpr int LDS_BYTES = 147456;

namespace pg8 {
constexpr int BM = 256, BK = 64, HALF = 128, HTB = HALF * BK * 2, STAGE_BYTES = 8 * HTB, NXCD = 8, WGM = 8;
__host__ __device__ __forceinline__ int lds_byte(int r, int c) { const int st = (r >> 4) * 2 + (c >> 5), rr = r & 15, cc = c & 31, ob = rr * 64 + cc * 2; return st * 1024 + (ob ^ (((ob >> 9) & 1) << 5)); }
__host__ __device__ __forceinline__ void stage_rc(int b, int& R, int& C) { const int st = b / 1024, sb = b % 1024, swz = sb ^ (((sb >> 9) & 1) << 5); R = (st >> 1) * 16 + swz / 64; C = (st & 1) * 32 + (swz % 64) / 2; }
__host__ __device__ __forceinline__ int perm32(int rho) { const int n = rho >> 4, i = rho & 15; return 8 * (i >> 2) + 4 * n + (i & 3); }
struct Unit { int pm, pn; };
struct Gemm { const bf16_t* A; const bf16_t* Bt; int lda, ldb, K; };
struct StaticOrder {
    int nM, nN, nwg, G, c;
    __device__ void init(int M, int N, int G_, int c_) { nM = M / BM; nN = N / BM; nwg = nM * nN; G = G_; c = c_; }
    __device__ bool next(int i, Unit& u) const {
        const long L = (long)i * G + c; if (L >= nwg) return false;
        int wgid = (int)L; { const int q = nwg / NXCD, r = nwg % NXCD, xcd = wgid % NXCD, off = wgid / NXCD; wgid = (xcd < r ? xcd * (q + 1) : r * (q + 1) + (xcd - r) * q) + off; }
        const int nig = WGM * nN, gid = wgid / nig, fm = gid * WGM, gsz = (nM - fm) < WGM ? (nM - fm) : WGM;
        u.pm = fm + ((wgid % nig) % gsz); u.pn = (wgid % nig) / gsz; return true;
    }
};
template <class Epi>
__device__ __forceinline__ void gemm_phase(LAS unsigned char* lds, const Gemm g, const StaticOrder& S, const Epi& E) {
    const int tid = fresh_tid(), wid = __builtin_amdgcn_readfirstlane(tid >> 6), lane = tid & 63, wr = wid >> 2, wc = wid & 3, fr = lane & 15, fq = lane >> 4;
    const int K = g.K, nt = K / BK;
    unsigned voffA[2], voffB[2];
#pragma unroll
    for (int i = 0; i < 2; ++i) { int R, C; stage_rc(tid * 16 + i * 8192, R, C); const int Rb = (R & ~31) + perm32(R & 31);
        voffA[i] = (unsigned)(R * g.lda + C) * 2u; voffB[i] = (unsigned)(Rb * g.ldb + C) * 2u; }
    const size_t kstep = (size_t)(BK * 2);
    const size_t hstepA = (size_t)HALF * g.lda * 2, hstepB = (size_t)HALF * g.ldb * 2;
    const size_t tstepA = 2 * hstepA, tstepB = 2 * hstepB;
    const unsigned ldsw = (unsigned)wid * 1024u;
    const int aoff = lds_byte(wr * 64 + fr, fq * 8), boff = lds_byte(wc * 32 + fr, fq * 8);
#define PG8_SA(b, h) (((b) * 2 + (h)) * HTB)
#define PG8_SB(b, h) ((4 + (b) * 2 + (h)) * HTB)
#define PG8_STAGE(bufoff, gbase, voff) do { _Pragma("unroll") for (int _i = 0; _i < 2; ++_i) \
        __builtin_amdgcn_global_load_lds((const unsigned*)((const char*)(gbase) + (voff)[_i]), (LAS unsigned*)(lds + (bufoff) + ldsw + _i * 8192), 16, 0, 0); } while (0)
#define PG8_LDA(dst, b, h) do { _Pragma("unroll") for (int m = 0; m < 4; ++m) _Pragma("unroll") for (int k = 0; k < 2; ++k) dst[m][k] = *(const LAS bf16x8*)(lds + PG8_SA(b, h) + aoff + m * 2048 + k * 1024); } while (0)
#define PG8_LDB(dst, b, h) do { _Pragma("unroll") for (int n = 0; n < 2; ++n) _Pragma("unroll") for (int k = 0; k < 2; ++k) dst[n][k] = *(const LAS bf16x8*)(lds + PG8_SB(b, h) + boff + n * 2048 + k * 1024); } while (0)
#define PG8_MMA(ai, bj, At, Bt) do { __builtin_amdgcn_s_setprio(1); _Pragma("unroll") for (int m = 0; m < 4; ++m) _Pragma("unroll") for (int n = 0; n < 2; ++n) _Pragma("unroll") for (int k = 0; k < 2; ++k) \
        acc[ai][bj][m][n] = __builtin_amdgcn_mfma_f32_16x16x32_bf16(Bt[n][k], At[m][k], acc[ai][bj][m][n], 0, 0, 0); __builtin_amdgcn_s_setprio(0); } while (0)
#define PG8_WAIT_V(n) asm volatile("s_waitcnt vmcnt(" #n ")" ::: "memory")
#define PG8_WAIT_L(n) asm volatile("s_waitcnt lgkmcnt(" #n ")" ::: "memory")
#define PG8_BAR __builtin_amdgcn_s_barrier()
#define PG8_SCHED __builtin_amdgcn_sched_barrier(0)
    Unit cur, nxt; int ui = 0;
    if (!S.next(0, cur)) return;
    f32x4 acc[2][2][4][2];
#pragma unroll
    for (int a = 0; a < 2; ++a)
#pragma unroll
        for (int b = 0; b < 2; ++b)
#pragma unroll
            for (int m = 0; m < 4; ++m)
#pragma unroll
                for (int n = 0; n < 2; ++n) acc[a][b][m][n] = (f32x4){0.f, 0.f, 0.f, 0.f};
    bf16x8 At[4][2], B0[2][2], B1[2][2];
    const char* cA = (const char*)g.A + (size_t)cur.pm * tstepA; const char* cB = (const char*)g.Bt + (size_t)cur.pn * tstepB;
    PG8_STAGE(PG8_SB(0, 0), cB, voffB); PG8_STAGE(PG8_SB(0, 1), cB + hstepB, voffB); PG8_STAGE(PG8_SA(0, 0), cA, voffA); PG8_STAGE(PG8_SA(0, 1), cA + hstepA, voffA);
    if (wr == 1) PG8_BAR;
    PG8_WAIT_V(2); PG8_BAR;
    PG8_STAGE(PG8_SB(1, 0), cB + kstep, voffB); PG8_STAGE(PG8_SA(1, 0), cA + kstep, voffA); PG8_STAGE(PG8_SB(1, 1), cB + hstepB + kstep, voffB);
    PG8_WAIT_V(6); PG8_BAR;
    for (;;) {
        const bool has_next = S.next(ui + 1, nxt);
        const char* nA = has_next ? (const char*)g.A + (size_t)nxt.pm * tstepA : cA; const char* nB = has_next ? (const char*)g.Bt + (size_t)nxt.pn * tstepB : cB;
        for (int t = 0; t < nt; t += 2) {
            const bool last = (t == nt - 2);
            const char* a1 = cA + (size_t)(t + 1) * kstep;
            const char* a2 = last ? nA : cA + (size_t)(t + 2) * kstep; const char* b2 = last ? nB : cB + (size_t)(t + 2) * kstep;
            const char* a3 = a2 + kstep; const char* b3 = b2 + kstep;
            PG8_LDB(B0, 0, 0); PG8_LDB(B1, 0, 1); PG8_SCHED; PG8_LDA(At, 0, 0); PG8_STAGE(PG8_SA(1, 1), a1 + hstepA, voffA);
            PG8_WAIT_V(8); PG8_WAIT_L(0); PG8_BAR; PG8_MMA(0, 0, At, B0); PG8_MMA(0, 1, At, B1); PG8_BAR; PG8_SCHED;
            PG8_LDA(At, 0, 1); PG8_STAGE(PG8_SB(0, 0), b2, voffB); PG8_STAGE(PG8_SB(0, 1), b2 + hstepB, voffB); PG8_STAGE(PG8_SA(0, 0), a2, voffA);
            PG8_WAIT_V(8); PG8_WAIT_L(0); PG8_BAR; PG8_MMA(1, 0, At, B0); PG8_MMA(1, 1, At, B1); PG8_BAR; PG8_SCHED;
            PG8_LDB(B0, 1, 0); PG8_LDB(B1, 1, 1); PG8_SCHED; PG8_LDA(At, 1, 0); PG8_STAGE(PG8_SA(0, 1), a2 + hstepA, voffA);
            PG8_WAIT_V(8); PG8_WAIT_L(0); PG8_BAR; PG8_MMA(0, 0, At, B0); PG8_MMA(0, 1, At, B1); PG8_BAR; PG8_SCHED;
            PG8_LDA(At, 1, 1); PG8_STAGE(PG8_SB(1, 0), b3, voffB); PG8_STAGE(PG8_SB(1, 1), b3 + hstepB, voffB); PG8_STAGE(PG8_SA(1, 0), a3, voffA);
            PG8_WAIT_V(8); PG8_WAIT_L(0); PG8_BAR; PG8_MMA(1, 0, At, B0); PG8_MMA(1, 1, At, B1); PG8_BAR; PG8_SCHED;
        }
        if (wr == 0) PG8_BAR;
        { const int l2_ = fresh_tid() & 63; E(acc, cur, wr, wc, l2_ & 15, l2_ >> 4); }
        if (!has_next) break;
#pragma unroll
        for (int a = 0; a < 2; ++a)
#pragma unroll
            for (int b = 0; b < 2; ++b)
#pragma unroll
                for (int m = 0; m < 4; ++m)
#pragma unroll
                    for (int n = 0; n < 2; ++n) acc[a][b][m][n] = (f32x4){0.f, 0.f, 0.f, 0.f};
        cur = nxt; cA = nA; cB = nB; ++ui;
        if (wr == 1) PG8_BAR;
    }
    PG8_WAIT_V(0);
    PG8_BAR;
#undef PG8_SA
#undef PG8_SB
#undef PG8_STAGE
#undef PG8_LDA
#undef PG8_LDB
#undef PG8_MMA
#undef PG8_WAIT_V
#undef PG8_WAIT_L
#undef PG8_BAR
#undef PG8_SCHED
}
typedef const f32x4 (&AccRef)[2][2][4][2];
__device__ __forceinline__ float sq4(const f32x4 v) { return (v[0] * v[0] + v[1] * v[1]) + (v[2] * v[2] + v[3] * v[3]); }
__device__ __forceinline__ u32x4 pack8(const f32x4 a, const f32x4 b) { u32x4 w; w.x = cvtpk(a[0], a[1]); w.y = cvtpk(a[2], a[3]); w.z = cvtpk(b[0], b[1]); w.w = cvtpk(b[2], b[3]); return w; }
__device__ __forceinline__ float fq_sum(float s) { s += __shfl_xor(s, 16); s += __shfl_xor(s, 32); return s; }

struct EpiProj { bf16_t* proj; float* ssq_q; float* ssq_kv; bf16_t* kpe; const float2* rope;
    __device__ __forceinline__ void operator()(AccRef acc, const Unit& u, int wr, int wc, int fr, int fq) const {
        const int row0 = u.pm * BM + wr * 64 + fr, col0 = u.pn * BM + wc * 32 + 8 * fq;
        const float sc = u.pn < 2 ? QSCALE_A : 1.f;
        const bool dorope = (u.pn == 7) && (wc == 0);
        float2 cs[2][4][4];
        if (dorope) {
#pragma unroll
            for (int ai = 0; ai < 2; ++ai)
#pragma unroll
                for (int m = 0; m < 4; ++m) { const int t = (row0 + ai * HALF + m * 16) & (SEQ - 1); const float2* cp = rope + t * 16 + 4 * fq;
#pragma unroll
                    for (int q = 0; q < 4; ++q) cs[ai][m][q] = cp[q]; }
        }
#pragma unroll
        for (int ai = 0; ai < 2; ++ai)
#pragma unroll
            for (int m = 0; m < 4; ++m) { const int row = row0 + ai * HALF + m * 16; bf16_t* rp = proj + (size_t)row * NPROJ + col0;
#pragma unroll
                for (int bj = 0; bj < 2; ++bj) *(u32x4*)(rp + bj * HALF) = pack8(acc[ai][bj][m][0] * sc, acc[ai][bj][m][1] * sc);
                if (u.pn == 6) { float s = (sq4(acc[ai][0][m][0]) + sq4(acc[ai][0][m][1])) + (sq4(acc[ai][1][m][0]) + sq4(acc[ai][1][m][1])); s = fq_sum(s); if (fq == 0) atomicAdd(ssq_q + row, s); }
                if (u.pn == 7) { float s = sq4(acc[ai][0][m][0]) + sq4(acc[ai][0][m][1]); s = fq_sum(s); if (fq == 0) atomicAdd(ssq_kv + row, s);
                    if (wc == 0) { f32x4 a = acc[ai][1][m][0], b = acc[ai][1][m][1];
                        const float2 c0 = cs[ai][m][0], c1 = cs[ai][m][1], c2 = cs[ai][m][2], c3 = cs[ai][m][3];
                        f32x4 ra, rb; ra[0] = a[0] * c0.x - a[1] * c0.y; ra[1] = a[1] * c0.x + a[0] * c0.y; ra[2] = a[2] * c1.x - a[3] * c1.y; ra[3] = a[3] * c1.x + a[2] * c1.y;
                        rb[0] = b[0] * c2.x - b[1] * c2.y; rb[1] = b[1] * c2.x + b[0] * c2.y; rb[2] = b[2] * c3.x - b[3] * c3.y; rb[3] = b[3] * c3.x + b[2] * c3.y;
                        *(u32x4*)(kpe + (size_t)row * 32 + 8 * fq) = pack8(ra, rb); } }
            }
    } };
struct EpiQ { bf16_t* qb; const float* ssq_q; const float2* rope;
    __device__ __forceinline__ void operator()(AccRef acc, const Unit& u, int wr, int wc, int fr, int fq) const {
        const int row0 = u.pm * BM + wr * 64 + fr, col0 = u.pn * BM + wc * 32 + 8 * fq;
        const int w0 = col0 % 96, w1 = (col0 + HALF) % 96; const bool pe0 = w0 >= 64, pe1 = w1 >= 64; const int j0 = pe0 ? (w0 - 64) >> 1 : (pe1 ? (w1 - 64) >> 1 : 0);
        float rr[2][4];
#pragma unroll
        for (int ai = 0; ai < 2; ++ai)
#pragma unroll
            for (int m = 0; m < 4; ++m) rr[ai][m] = ssq_q[row0 + ai * HALF + m * 16];
#pragma unroll
        for (int ai = 0; ai < 2; ++ai) {
            f32x4 cs[4][2];
#pragma unroll
            for (int m = 0; m < 4; ++m) { cs[m][0] = (f32x4){1.f, 0.f, 1.f, 0.f}; cs[m][1] = cs[m][0];
                if (pe0 || pe1) { const f32x4* cp = (const f32x4*)(rope + ((row0 + ai * HALF + m * 16) & (SEQ - 1)) * 16 + j0); cs[m][0] = cp[0]; cs[m][1] = cp[1]; } }
#pragma unroll
            for (int m = 0; m < 4; ++m) asm volatile("" : "+v"(cs[m][0]), "+v"(cs[m][1]));
            __builtin_amdgcn_sched_barrier(0);
#pragma unroll
            for (int m = 0; m < 4; ++m) { const int row = row0 + ai * HALF + m * 16; const float r = rsqrtf(rr[ai][m] * (1.f / 256.f) + EPS);
#pragma unroll
                for (int bj = 0; bj < 2; ++bj) { f32x4 a = acc[ai][bj][m][0] * r, b = acc[ai][bj][m][1] * r;
                    if (bj == 0 ? pe0 : pe1) { const f32x4 ca = cs[m][0], cb = cs[m][1]; f32x4 ra, rb;
                        ra[0] = a[0] * ca[0] - a[1] * ca[1]; ra[1] = a[1] * ca[0] + a[0] * ca[1]; ra[2] = a[2] * ca[2] - a[3] * ca[3]; ra[3] = a[3] * ca[2] + a[2] * ca[3];
                        rb[0] = b[0] * cb[0] - b[1] * cb[1]; rb[1] = b[1] * cb[0] + b[0] * cb[1]; rb[2] = b[2] * cb[2] - b[3] * cb[3]; rb[3] = b[3] * cb[2] + b[2] * cb[3]; a = ra; b = rb; }
                    *(u32x4*)(qb + (size_t)row * NQB + col0 + bj * HALF) = pack8(a * QSCALE_B, b * QSCALE_B); } }
        }
    } };
struct EpiKV { bf16_t* kvb; const float* ssq_kv;
    __device__ __forceinline__ void operator()(AccRef acc, const Unit& u, int wr, int wc, int fr, int fq) const {
        const int row0 = u.pm * BM + wr * 64 + fr, col0 = u.pn * BM + wc * 32 + 8 * fq;
        float rr[2][4];
#pragma unroll
        for (int ai = 0; ai < 2; ++ai)
#pragma unroll
            for (int m = 0; m < 4; ++m) rr[ai][m] = ssq_kv[row0 + ai * HALF + m * 16];
#pragma unroll
        for (int ai = 0; ai < 2; ++ai)
#pragma unroll
            for (int m = 0; m < 4; ++m) { const int row = row0 + ai * HALF + m * 16; const float r = rsqrtf(rr[ai][m] * (1.f / 128.f) + EPS);
#pragma unroll
                for (int bj = 0; bj < 2; ++bj) *(u32x4*)(kvb + (size_t)row * NKVB + col0 + bj * HALF) = pack8(acc[ai][bj][m][0] * r, acc[ai][bj][m][1] * r); }
    } };
__device__ __forceinline__ f32x4 bf4lo(const u32x4 w) { f32x4 r; r[0] = __builtin_bit_cast(float, w.x << 16); r[1] = __builtin_bit_cast(float, w.x & 0xffff0000u); r[2] = __builtin_bit_cast(float, w.y << 16); r[3] = __builtin_bit_cast(float, w.y & 0xffff0000u); return r; }
__device__ __forceinline__ f32x4 bf4hi(const u32x4 w) { f32x4 r; r[0] = __builtin_bit_cast(float, w.z << 16); r[1] = __builtin_bit_cast(float, w.z & 0xffff0000u); r[2] = __builtin_bit_cast(float, w.w << 16); r[3] = __builtin_bit_cast(float, w.w & 0xffff0000u); return r; }
struct EpiOut { const bf16_t* xn; const float* xrs; bf16_t* h1b; float* ssq;
    __device__ __forceinline__ void operator()(AccRef acc, const Unit& u, int wr, int wc, int fr, int fq) const {
        const int row0 = u.pm * BM + wr * 64 + fr, col0 = u.pn * BM + wc * 32 + 8 * fq;
        u32x4 xw[2][4][2]; float rs[2][4];
#pragma unroll
        for (int ai = 0; ai < 2; ++ai)
#pragma unroll
            for (int m = 0; m < 4; ++m) { const int row = row0 + ai * HALF + m * 16; rs[ai][m] = xrs[row];
#pragma unroll
                for (int bj = 0; bj < 2; ++bj) xw[ai][m][bj] = *(const u32x4*)(xn + (size_t)row * DM + col0 + bj * HALF); }
#pragma unroll
        for (int ai = 0; ai < 2; ++ai)
#pragma unroll
            for (int m = 0; m < 4; ++m) { const int row = row0 + ai * HALF + m * 16; const size_t off = (size_t)row * DM + col0; const float r = rs[ai][m]; float s = 0.f;
#pragma unroll
                for (int bj = 0; bj < 2; ++bj) { const f32x4 a = bf4lo(xw[ai][m][bj]) * r + acc[ai][bj][m][0], b = bf4hi(xw[ai][m][bj]) * r + acc[ai][bj][m][1];
                    *(u32x4*)(h1b + off + bj * HALF) = pack8(a, b); s += sq4(a) + sq4(b); }
                s = fq_sum(s); if (fq == 0) atomicAdd(ssq + row, s); }
    } };
struct EpiUp { bf16_t* act; const float* ssq;
    __device__ __forceinline__ void operator()(AccRef acc, const Unit& u, int wr, int wc, int fr, int fq) const {
        const int row0 = u.pm * BM + wr * 64 + fr, col0 = u.pn * BM + wc * 32 + 8 * fq;
        float rr[2][4];
#pragma unroll
        for (int ai = 0; ai < 2; ++ai)
#pragma unroll
            for (int m = 0; m < 4; ++m) rr[ai][m] = ssq[row0 + ai * HALF + m * 16];
#pragma unroll
        for (int ai = 0; ai < 2; ++ai)
#pragma unroll
            for (int m = 0; m < 4; ++m) { const int row = row0 + ai * HALF + m * 16; const float r = rsqrtf(rr[ai][m] * (1.f / DM) + EPS);
#pragma unroll
                for (int bj = 0; bj < 2; ++bj) { f32x4 a = acc[ai][bj][m][0] * r, b = acc[ai][bj][m][1] * r;
#pragma unroll
                    for (int e = 0; e < 4; ++e) { const float ta = fmaxf(a[e], 0.f), tb = fmaxf(b[e], 0.f); a[e] = ta * ta; b[e] = tb * tb; }
                    *(u32x4*)(act + (size_t)row * DFF + col0 + bj * HALF) = pack8(a, b); } }
    } };
struct EpiDown { const bf16_t* h1b; float* h; float* ssq;
    __device__ __forceinline__ void operator()(AccRef acc, const Unit& u, int wr, int wc, int fr, int fq) const {
        const int row0 = u.pm * BM + wr * 64 + fr, col0 = u.pn * BM + wc * 32 + 8 * fq;
#pragma unroll
        for (int ai = 0; ai < 2; ++ai)
#pragma unroll
            for (int m = 0; m < 4; ++m) { const int row = row0 + ai * HALF + m * 16; const size_t off = (size_t)row * DM + col0; float s = 0.f;
#pragma unroll
                for (int bj = 0; bj < 2; ++bj) { const u32x4 hw = *(const u32x4*)(h1b + off + bj * HALF); const f32x4 a = bf4lo(hw) + acc[ai][bj][m][0], b = bf4hi(hw) + acc[ai][bj][m][1];
                    *(f32x4*)(h + off + bj * HALF) = a; *(f32x4*)(h + off + bj * HALF + 4) = b; s += sq4(a) + sq4(b); }
                s = fq_sum(s); if (fq == 0) atomicAdd(ssq + row, s); }
    } };
struct EpiDownFused { const bf16_t* h1b; float* out; const float* gfin; float* xbuf; unsigned* cnt; LAS unsigned char* scr;
    __device__ __forceinline__ void operator()(f32x4 (&acc)[2][2][4][2], const Unit& u, int wr, int wc, int fr, int fq) const {
        LAS float* P = (LAS float*)scr; LAS float* S = (LAS float*)(scr + 4096);
        const int row0 = u.pm * BM + wr * 64 + fr, col0 = u.pn * BM + wc * 32 + 8 * fq;
        u32x4 hw[2][4][2]; f32x4 g[2][2];
#pragma unroll
        for (int ai = 0; ai < 2; ++ai)
#pragma unroll
            for (int m = 0; m < 4; ++m)
#pragma unroll
                for (int bj = 0; bj < 2; ++bj) hw[ai][m][bj] = *(const u32x4*)(h1b + (size_t)(row0 + ai * HALF + m * 16) * DM + col0 + bj * HALF);
#pragma unroll
        for (int bj = 0; bj < 2; ++bj) { g[bj][0] = *(const f32x4*)(gfin + col0 + bj * HALF); g[bj][1] = *(const f32x4*)(gfin + col0 + bj * HALF + 4); }
#pragma unroll
        for (int ai = 0; ai < 2; ++ai)
#pragma unroll
            for (int m = 0; m < 4; ++m) { float s = 0.f;
#pragma unroll
                for (int bj = 0; bj < 2; ++bj) { acc[ai][bj][m][0] += bf4lo(hw[ai][m][bj]); acc[ai][bj][m][1] += bf4hi(hw[ai][m][bj]); s += sq4(acc[ai][bj][m][0]) + sq4(acc[ai][bj][m][1]); }
                s = fq_sum(s); if (fq == 0) P[(ai * HALF + wr * 64 + m * 16 + fr) * 4 + wc] = s; }
        asm volatile("s_waitcnt lgkmcnt(0)\n\ts_barrier" ::: "memory");
        const int t = threadIdx.x;
        if (t < 256) { const float tot = (P[t * 4] + P[t * 4 + 1]) + (P[t * 4 + 2] + P[t * 4 + 3]);
            __hip_atomic_store(xbuf + (size_t)(u.pm * BM + t) * 4 + u.pn, tot, __ATOMIC_RELAXED, __HIP_MEMORY_SCOPE_AGENT); }
        asm volatile("s_waitcnt vmcnt(0)" ::: "memory");
        if (t < 256 && (t & 63) == 0) __hip_atomic_fetch_add(cnt + 64 * u.pm, 1u, __ATOMIC_RELAXED, __HIP_MEMORY_SCOPE_AGENT);
        if (t < 64) { unsigned spins = 0;
            while ((unsigned)__builtin_amdgcn_readfirstlane(__hip_atomic_load(cnt + 64 * u.pm, __ATOMIC_RELAXED, __HIP_MEMORY_SCOPE_AGENT)) < 16u) { __builtin_amdgcn_s_sleep(1); if (++spins > (1u << 22)) break; }
            __builtin_amdgcn_fence(__ATOMIC_ACQUIRE, "agent"); }
        asm volatile("s_waitcnt vmcnt(0) lgkmcnt(0)\n\ts_barrier" ::: "memory");
        if (t < 256) { const float* sl = xbuf + (size_t)(u.pm * BM + t) * 4; float tot = 0.f;
#pragma unroll
            for (int q = 0; q < 4; ++q) tot += __hip_atomic_load(sl + q, __ATOMIC_RELAXED, __HIP_MEMORY_SCOPE_AGENT);
            S[t] = rsqrtf(tot * (1.f / DM) + EPS); }
        asm volatile("s_waitcnt vmcnt(0) lgkmcnt(0)\n\ts_barrier" ::: "memory");
#pragma unroll
        for (int ai = 0; ai < 2; ++ai)
#pragma unroll
            for (int m = 0; m < 4; ++m) { const int rl = ai * HALF + wr * 64 + m * 16 + fr; const float r = S[rl]; const size_t off = (size_t)(u.pm * BM + rl) * DM + col0;
#pragma unroll
                for (int bj = 0; bj < 2; ++bj) { *(f32x4*)(out + off + bj * HALF) = acc[ai][bj][m][0] * g[bj][0] * r; *(f32x4*)(out + off + bj * HALF + 4) = acc[ai][bj][m][1] * g[bj][1] * r; } }
        asm volatile("s_waitcnt lgkmcnt(0)\n\ts_barrier" ::: "memory");
    } };
}

namespace mla {
constexpr int KPITCH = 208, KBUF = 64 * KPITCH, VBUF = 8192;
constexpr int OFF_K = 0, OFF_V = 2 * KBUF, LDS_NEED = 2 * KBUF + 3 * VBUF;
constexpr int NT = SEQ / 64;
constexpr float THR = 8.0f;
constexpr float PTHR = 256.0f;
#define MSB() __builtin_amdgcn_sched_barrier(0)
#define MPIN(x) asm volatile("" : "+v"(x))
#define MX3(a, b, c) __builtin_fmaxf(__builtin_fmaxf((a), (b)), (c))
#define MFMA32(a, b, c) __builtin_amdgcn_mfma_f32_32x32x16_bf16((a), (b), (c), 0, 0, 0)
#define LBAR() do { if (VAR != 1 && VAR != 10 && VAR != 11) asm volatile("s_waitcnt lgkmcnt(0)\n\ts_barrier" ::: "memory"); } while (0)
__device__ __forceinline__ float swapmax(float v) { auto rr = __builtin_amdgcn_permlane32_swap(__float_as_uint(v), __float_as_uint(v), false, false); return __builtin_fmaxf(__uint_as_float(rr[0]), __uint_as_float(rr[1])); }
__device__ __forceinline__ float swapsum(float v) { auto rr = __builtin_amdgcn_permlane32_swap(__float_as_uint(v), __float_as_uint(v), false, false); return __uint_as_float(rr[0]) + __uint_as_float(rr[1]); }
template <int VAR> __device__ __forceinline__ bf16x8 kfrag_(const LAS unsigned char* p, const bf16x8 dummy) { if (VAR == 5 || VAR == 7 || VAR == 10 || VAR == 11) { bf16x8 d = dummy; asm volatile("" : "+v"(d)); return d; } return *(const LAS bf16x8*)p; }
template <int VAR> __device__ __forceinline__ bf16x8 vfrag_(const LAS unsigned char* p, const bf16x8 dummy) { if (VAR == 6 || VAR == 7 || VAR == 10 || VAR == 11) { bf16x8 d = dummy; asm volatile("" : "+v"(d)); return d; } const s16x4 lo = tr16(p), hi = tr16(p + 1024); return __builtin_shufflevector(lo, hi, 0, 1, 2, 3, 4, 5, 6, 7); }
#define kfrag(p) kfrag_<VAR>((p), qr[0])
#define vfrag(p) vfrag_<VAR>((p), qr[1])

__device__ __forceinline__ f32x16 pinacc(f32x16 c, bf16x8 a, bf16x8 b) { asm volatile("" : "+v"(c) : "v"(a), "v"(b)); return c; }
template <int VAR>
__device__ __forceinline__ void unit(LAS unsigned char* lds, int b, int h, int qblk, const bf16_t* __restrict__ Q, const bf16_t* __restrict__ KV, const bf16_t* __restrict__ KPE, bf16_t* __restrict__ O) {
    if (VAR == 12) return;
    constexpr int NT = (VAR == 13) ? mla::NT / 2 : ((VAR == 14) ? 4 : mla::NT);
    const int tid = fresh_tid(), lane = tid & 63, wid = __builtin_amdgcn_readfirstlane(tid >> 6), r32 = lane & 31, hi = lane >> 5;
    const size_t row0 = (size_t)b * SEQ;
    const int srow = tid >> 3, sch = tid & 7;
    const bf16_t* srcA = KV + (row0 + srow) * NKVB + 128 * h + 8 * sch;
    const bf16_t* srcB = srcA + 64;
    const bf16_t* srcC = KPE + (row0 + (tid >> 2)) * 32 + 8 * (tid & 3);
    const int dstA = OFF_K + srow * KPITCH + sch * 16;
    const int dstB = OFF_V + ((srow >> 3) * 2 + (sch >> 2)) * 512 + (srow & 7) * 64 + (sch & 3) * 16;
    const int dstC = OFF_K + (tid >> 2) * KPITCH + 128 + (tid & 3) * 16;
    const bool hasC = tid < 256;
    constexpr size_t TSA = (size_t)64 * NKVB, TSC = (size_t)64 * 32;
    u32x4 a0, b0, c0 = (u32x4){0u, 0u, 0u, 0u}, a1, b1, c1 = (u32x4){0u, 0u, 0u, 0u};
    { const u32x4 ka = *(const u32x4*)srcA; u32x4 kc = (u32x4){0u, 0u, 0u, 0u}; if (hasC) kc = *(const u32x4*)srcC;
      a0 = *(const u32x4*)(srcA + TSA); b0 = *(const u32x4*)srcB; if (hasC) c0 = *(const u32x4*)(srcC + TSC);
      a1 = *(const u32x4*)(srcA + 2 * TSA); b1 = *(const u32x4*)(srcB + TSA); if (hasC) c1 = *(const u32x4*)(srcC + 2 * TSC);
      *(LAS u32x4*)(lds + dstA) = ka; if (hasC) *(LAS u32x4*)(lds + dstC) = kc; }
    const bf16_t* qp = Q + (row0 + qblk * 256 + wid * 32 + r32) * NQB + 96 * h + 8 * hi;
    bf16x8 qr[6];
#pragma unroll
    for (int s = 0; s < 6; ++s) qr[s] = *(const bf16x8*)(qp + 16 * s);
    f32x16 o0, o1, negm, pA0, pA1, pB0, pB1;
#pragma unroll
    for (int i = 0; i < 16; ++i) { o0[i] = 0.f; o1[i] = 0.f; negm[i] = 0.f; }
    MPIN(negm);
    float mref = 0.f, lrun = 0.f, fres = 1.f; bool resc = false;
    const LAS unsigned char* kf0 = lds + OFF_K + r32 * KPITCH + 16 * hi;
    const LAS unsigned char* vf0 = lds + OFF_V + (4 * hi + ((lane & 15) >> 2)) * 64 + ((lane >> 4) & 1) * 32 + (lane & 3) * 8;
    LBAR();
    u32x4 pw0, pw1, pw2, pw3;
#define PKW(P, B) cvtpk(P[B], P[B + 1])
#define PAF(k) __builtin_bit_cast(bf16x8, pw##k)
#define KFC(f) kfrag(kp_ + ((f) & 1) * 32 * KPITCH + 32 * ((f) >> 1))
#define KFN(f) kfrag(kn_ + ((f) & 1) * 32 * KPITCH + 32 * ((f) >> 1))
#define SUM4(P, B) do { if (VAR == 4 || VAR == 10 || VAR == 11) break; sacc += P[B]; sacc += P[B + 1]; sacc += P[B + 2]; sacc += P[B + 3]; MPIN(sacc); } while (0)
#define PK2(PW, i, P, B) do { PW[i] = PKW(P, B); PW[(i) + 1] = PKW(P, (B) + 2); MPIN(PW); } while (0)
#define STAGE_K(SA, SC, s) do { if (VAR == 3 || VAR == 10 || VAR == 11) break; const int kw_ = (((s) + 1) & 1) * KBUF; *(LAS u32x4*)(lds + kw_ + dstA) = SA; if (hasC) *(LAS u32x4*)(lds + kw_ + dstC) = SC; \
        const int tk_ = (s) + 3 < NT ? (s) + 3 : NT - 1; SA = *(const u32x4*)(srcA + (size_t)tk_ * TSA); if (hasC) SC = *(const u32x4*)(srcC + (size_t)tk_ * TSC); } while (0)
#define STAGE_V(SB, s) do { if (VAR == 3 || VAR == 10 || VAR == 11) break; *(LAS u32x4*)(lds + vslot * VBUF + dstB) = SB; const int tv_ = (s) + 2 < NT ? (s) + 2 : NT - 1; SB = *(const u32x4*)(srcB + (size_t)tv_ * TSA); } while (0)
#define DECIDE(C0, C1) do { float a_ = MX3(C0[0], C0[1], C1[0]), b_ = MX3(C0[2], C0[3], C1[1]); a_ = MX3(a_, C1[2], C1[3]); \
        _Pragma("unroll") for (int r = 4; r < 16; r += 4) { a_ = MX3(a_, C0[r], C0[r + 1]); b_ = MX3(b_, C0[r + 2], C0[r + 3]); a_ = MX3(a_, C1[r], C1[r + 1]); b_ = MX3(b_, C1[r + 2], C1[r + 3]); } \
        const float rm_ = swapmax(__builtin_fmaxf(a_, b_)); resc = false; \
        if (__builtin_expect(__any(rm_ > THR), 0)) { const float dl_ = __builtin_fmaxf(rm_, 0.f); mref += dl_; \
            _Pragma("unroll") for (int r = 0; r < 16; ++r) { C0[r] -= dl_; C1[r] -= dl_; } \
            _Pragma("unroll") for (int r = 0; r < 16; ++r) negm[r] = -mref; MPIN(negm); \
            fres = __builtin_amdgcn_exp2f(-dl_); lrun *= fres; resc = true; } } while (0)
#define EXP4(X, B) do { if (VAR == 2 || VAR == 10 || VAR == 11) { MPIN(X); break; } X[B] = __builtin_amdgcn_exp2f(X[B]); X[B + 1] = __builtin_amdgcn_exp2f(X[B + 1]); X[B + 2] = __builtin_amdgcn_exp2f(X[B + 2]); X[B + 3] = __builtin_amdgcn_exp2f(X[B + 3]); MPIN(X); } while (0)
#define LAGDECIDE(P0, P1, N0, N1, M) do { const float rm_ = swapmax(M); resc = false;   \
        if (__builtin_expect(__any(rm_ > PTHR), 0)) { const float dl_ = __builtin_fmaxf(__builtin_amdgcn_logf(rm_), 0.f); fres = __builtin_amdgcn_exp2f(-dl_); mref += dl_; \
            _Pragma("unroll") for (int r = 0; r < 16; ++r) { N0[r] -= dl_; N1[r] -= dl_; negm[r] = -mref; } MPIN(negm); \
            lrun *= fres; resc = true; } } while (0)
#define MFMAB(a, b, c) ((VAR == 8 || VAR == 11) ? pinacc(c, a, b) : MFMA32(a, b, c))
#define MFMAA(a, b, c) ((VAR == 9 || VAR == 11) ? pinacc(c, a, b) : MFMA32(a, b, c))
#define EXP1(X, i) X[i] = __builtin_amdgcn_exp2f(X[i])
#define EXP3(X, a, Y, b, Z, c) do { if (VAR == 2 || VAR == 10 || VAR == 11) { MPIN(X); break; } EXP1(X, a); EXP1(Y, b); EXP1(Z, c); MPIN(X); MPIN(Y); MPIN(Z); } while (0)
#define EXP2(X, a, Y, b) do { if (VAR == 2 || VAR == 10 || VAR == 11) { MPIN(X); break; } EXP1(X, a); EXP1(Y, b); MPIN(X); MPIN(Y); } while (0)
#define STEP(N0, N1, P0, P1, SA, SB, SC, s) do { \
        STAGE_K(SA, SC, s); STAGE_V(SB, s); MSB(); \
        const LAS unsigned char* kp_ = kf0 + ((s) & 1) * KBUF; const LAS unsigned char* kn_ = kf0 + (((s) + 1) & 1) * KBUF; const LAS unsigned char* vp_ = vf0 + vprev * VBUF; \
        bf16x8 v0_, v1_, v2_, v3_; float sacc = 0.f; \
        N0 = MFMAA(k4, qr[2], N0); k4 = KFC(10); SUM4(P0, 0);  PK2(pw0, 0, P0, 0);  MSB(); \
        N1 = MFMAA(k5, qr[2], N1); k5 = KFC(11); SUM4(P0, 4);  PK2(pw0, 2, P0, 4);  MSB(); \
        N0 = MFMAA(k0, qr[3], N0);               SUM4(P0, 8);  PK2(pw1, 0, P0, 8);  MSB(); \
        N1 = MFMAA(k1, qr[3], N1);               SUM4(P0, 12); PK2(pw1, 2, P0, 12); MSB(); \
        N0 = MFMAA(k2, qr[4], N0); v0_ = vfrag(vp_);       SUM4(P1, 0);  PK2(pw2, 0, P1, 0);  MSB(); \
        N1 = MFMAA(k3, qr[4], N1); v1_ = vfrag(vp_ + 512); SUM4(P1, 4);  PK2(pw2, 2, P1, 4);  MSB(); \
        N0 = MFMAA(k4, qr[5], N0); v2_ = vfrag(vp_ + 2048);       SUM4(P1, 8);  PK2(pw3, 0, P1, 8);  MSB(); \
        N1 = MFMAA(k5, qr[5], N1); v3_ = vfrag(vp_ + 2048 + 512); SUM4(P1, 12); PK2(pw3, 2, P1, 12); MSB(); \
        lrun += sacc; \
        LAGDECIDE(P0, P1, N0, N1, sacc); MSB(); \
        LBAR(); \
        vprev = vslot; vslot = (vslot == 2) ? 0 : vslot + 1; \
        k0 = KFN(0); k1 = KFN(1); MSB(); \
        o0 = MFMAB(v0_, PAF(0), o0); v0_ = vfrag(vp_ + 4096);       k2 = KFN(2); EXP3(N0, 0, N0, 1, N0, 2);    MSB(); \
        o1 = MFMAB(v1_, PAF(0), o1); v1_ = vfrag(vp_ + 4096 + 512); k3 = KFN(3); EXP3(N0, 3, N0, 4, N0, 5);    MSB(); \
        o0 = MFMAB(v2_, PAF(1), o0); v2_ = vfrag(vp_ + 6144);       k4 = KFN(4); EXP3(N0, 6, N0, 7, N0, 8);    MSB(); \
        o1 = MFMAB(v3_, PAF(1), o1); v3_ = vfrag(vp_ + 6144 + 512); k5 = KFN(5); EXP3(N0, 9, N0, 10, N0, 11); MSB(); \
        o0 = MFMAB(v0_, PAF(2), o0); EXP3(N0, 12, N0, 13, N0, 14); MSB(); \
        o1 = MFMAB(v1_, PAF(2), o1); EXP3(N0, 15, N1, 0, N1, 1);   MSB(); \
        o0 = MFMAB(v2_, PAF(3), o0); EXP3(N1, 2, N1, 3, N1, 4); MSB(); \
        o1 = MFMAB(v3_, PAF(3), o1); EXP3(N1, 5, N1, 6, N1, 7); MSB(); \
        P0 = MFMAA(k0, qr[0], negm); k0 = KFN(6); EXP2(N1, 8, N1, 9);   MSB(); \
        P1 = MFMAA(k1, qr[0], negm); k1 = KFN(7); EXP2(N1, 10, N1, 11); MSB(); \
        P0 = MFMAA(k2, qr[1], P0);   k2 = KFN(8); EXP2(N1, 12, N1, 13); MSB(); \
        P1 = MFMAA(k3, qr[1], P1);   k3 = KFN(9); EXP2(N1, 14, N1, 15); MSB(); \
        if (resc) { _Pragma("unroll") for (int r = 0; r < 16; ++r) { o0[r] *= fres; o1[r] *= fres; } } \
        } while (0)
#define QK2(C0, C1, ds, INIT) do { const bf16x8 ka_ = kfrag(kp_ + 32 * (ds)), kb_ = kfrag(kp_ + 32 * KPITCH + 32 * (ds)); \
        C0 = MFMA32(ka_, qr[ds], INIT ? negm : C0); C1 = MFMA32(kb_, qr[ds], INIT ? negm : C1); } while (0)
    bf16x8 k0, k1, k2, k3, k4, k5;
    int vslot = 0, vprev = 0;
    {
        STAGE_K(a0, c0, 0); STAGE_V(b0, 0); MSB();
        const LAS unsigned char* kp_ = kf0; const LAS unsigned char* kn_ = kf0 + KBUF;
        QK2(pA0, pA1, 0, true); QK2(pA0, pA1, 1, false); QK2(pA0, pA1, 2, false); QK2(pA0, pA1, 3, false); QK2(pA0, pA1, 4, false); QK2(pA0, pA1, 5, false);
        float a_ = MX3(pA0[0], pA0[1], pA1[0]), b_ = MX3(pA0[2], pA0[3], pA1[1]); a_ = MX3(a_, pA1[2], pA1[3]);
#pragma unroll
        for (int r = 4; r < 16; r += 4) { a_ = MX3(a_, pA0[r], pA0[r + 1]); b_ = MX3(b_, pA0[r + 2], pA0[r + 3]); a_ = MX3(a_, pA1[r], pA1[r + 1]); b_ = MX3(b_, pA1[r + 2], pA1[r + 3]); }
        const float rm_ = swapmax(__builtin_fmaxf(a_, b_));
        mref = rm_;
#pragma unroll
        for (int r = 0; r < 16; ++r) { pA0[r] = __builtin_amdgcn_exp2f(pA0[r] - rm_); pA1[r] = __builtin_amdgcn_exp2f(pA1[r] - rm_); negm[r] = -mref; }
        MPIN(negm);
        LBAR();
        vprev = vslot; vslot = 1;
        k0 = KFN(0); k1 = KFN(1); k2 = KFN(2); k3 = KFN(3); k4 = KFN(4); k5 = KFN(5);
        pB0 = MFMA32(k0, qr[0], negm); pB1 = MFMA32(k1, qr[0], negm); pB0 = MFMA32(k2, qr[1], pB0); pB1 = MFMA32(k3, qr[1], pB1);
        k0 = KFN(6); k1 = KFN(7); k2 = KFN(8); k3 = KFN(9);
    }
    for (int s = 1; s + 1 < NT; s += 2) {
        STEP(pB0, pB1, pA0, pA1, a1, b1, c1, s);
        STEP(pA0, pA1, pB0, pB1, a0, b0, c0, s + 1);
    }
    STEP(pB0, pB1, pA0, pA1, a1, b1, c1, NT - 1);
    LBAR();
    {
        float sacc = 0.f;
#pragma unroll
        for (int r = 0; r < 16; ++r) sacc += pB0[r] + pB1[r];
        lrun += sacc;
        pw0 = (u32x4){PKW(pB0, 0), PKW(pB0, 2), PKW(pB0, 4), PKW(pB0, 6)}; pw1 = (u32x4){PKW(pB0, 8), PKW(pB0, 10), PKW(pB0, 12), PKW(pB0, 14)};
        pw2 = (u32x4){PKW(pB1, 0), PKW(pB1, 2), PKW(pB1, 4), PKW(pB1, 6)}; pw3 = (u32x4){PKW(pB1, 8), PKW(pB1, 10), PKW(pB1, 12), PKW(pB1, 14)};
        const LAS unsigned char* vp_ = vf0 + vprev * VBUF;
        { const bf16x8 v0_ = vfrag(vp_), v1_ = vfrag(vp_ + 512); o0 = MFMA32(v0_, PAF(0), o0); o1 = MFMA32(v1_, PAF(0), o1); }
        { const bf16x8 v0_ = vfrag(vp_ + 2048), v1_ = vfrag(vp_ + 2048 + 512); o0 = MFMA32(v0_, PAF(1), o0); o1 = MFMA32(v1_, PAF(1), o1); }
        { const bf16x8 v0_ = vfrag(vp_ + 4096), v1_ = vfrag(vp_ + 4096 + 512); o0 = MFMA32(v0_, PAF(2), o0); o1 = MFMA32(v1_, PAF(2), o1); }
        { const bf16x8 v0_ = vfrag(vp_ + 6144), v1_ = vfrag(vp_ + 6144 + 512); o0 = MFMA32(v0_, PAF(3), o0); o1 = MFMA32(v1_, PAF(3), o1); }
    }
    lrun = swapsum(lrun);
    const float inv = 1.f / lrun;
    bf16_t* op = O + (row0 + qblk * 256 + wid * 32 + r32) * DM + 512 + 64 * h + 4 * hi;
#pragma unroll
    for (int i = 0; i < 4; ++i) {
        u32x2 w; w.x = cvtpk(o0[4 * i] * inv, o0[4 * i + 1] * inv); w.y = cvtpk(o0[4 * i + 2] * inv, o0[4 * i + 3] * inv); *(u32x2*)(op + 8 * i) = w;
        u32x2 z; z.x = cvtpk(o1[4 * i] * inv, o1[4 * i + 1] * inv); z.y = cvtpk(o1[4 * i + 2] * inv, o1[4 * i + 3] * inv); *(u32x2*)(op + 32 + 8 * i) = z;
    }
    LBAR();
#undef PKW
#undef PAF
#undef STAGE_K
#undef STAGE_V
#undef QK2
#undef SUM4
#undef PK2
#undef KFC
#undef KFN
#undef DECIDE
#undef LAGDECIDE
#undef EXP4
#undef EXP1
#undef EXP2
#undef EXP3
#undef STEP
}
#undef kfrag
#undef vfrag
#undef MSB
#undef MPIN
#undef MX3
#undef MFMA32
#undef LBAR
}

namespace dil {
constexpr int EXT_OFF1 = 176, EXT_OFF2 = 428, EXT_H = 1052;
constexpr float THR = 8.0f;
constexpr int ROWB = NPROJ * 2;
__device__ __forceinline__ void build_ext(LAS float* ext, const float* __restrict__ rel_bias) {
    for (int i = threadIdx.x; i < 8 * EXT_H; i += NTHREADS) { const int h = i / EXT_H, k = i % EXT_H;
        int d, j; if (k < EXT_OFF1) { d = 16; j = k - 79; } else if (k < EXT_OFF2) { d = 4; j = k - EXT_OFF1 - 124; } else { d = 1; j = k - EXT_OFF2 - 304; }
        ext[i] = (j >= -64 && j <= 64) ? rel_bias[t5_bucket(d * j) * 8 + h] * LOG2E : -__builtin_inff(); }
}
struct Frags { u32x4 k0, k1, k2, k3; u32x4 v0, v1, v2, v3; };
template <int LD>
struct Pat {
    static constexpr int D = 1 << LD, QS = 16 >> LD, LMAX = SEQ >> LD;
    static __device__ __forceinline__ void load(Frags& f, const bf16_t* __restrict__ prow, int Lb, int rem, int c, unsigned offK, unsigned offV, int vrow, unsigned kcol, unsigned vcol) {
        const int lbase = Lb - 64 + 32 * c;
        if (lbase >= 0 && lbase + 31 < LMAX) {
            const char* ub = (const char*)prow + (size_t)((lbase << LD) + rem) * ROWB;
            constexpr size_t R8 = (size_t)(8 << LD) * ROWB;
            f.k0 = *(const u32x4*)(ub + offK); f.k1 = *(const u32x4*)(ub + offK + R8); f.k2 = *(const u32x4*)(ub + offK + 2 * R8); f.k3 = *(const u32x4*)(ub + offK + 3 * R8);
            f.v0 = *(const u32x4*)(ub + offV); f.v1 = *(const u32x4*)(ub + offV + R8); f.v2 = *(const u32x4*)(ub + offV + 2 * R8); f.v3 = *(const u32x4*)(ub + offV + 3 * R8);
        } else {
            auto rowp = [&](int l) { l = l < 0 ? 0 : (l > LMAX - 1 ? LMAX - 1 : l); return (const char*)prow + (size_t)((l << LD) + rem) * ROWB; };
            const char* r0 = rowp(lbase + vrow); const char* r1 = rowp(lbase + vrow + 8); const char* r2 = rowp(lbase + vrow + 16); const char* r3 = rowp(lbase + vrow + 24);
            f.k0 = *(const u32x4*)(r0 + kcol); f.k1 = *(const u32x4*)(r1 + kcol); f.k2 = *(const u32x4*)(r2 + kcol); f.k3 = *(const u32x4*)(r3 + kcol);
            f.v0 = *(const u32x4*)(r0 + vcol); f.v1 = *(const u32x4*)(r1 + vcol); f.v2 = *(const u32x4*)(r2 + vcol); f.v3 = *(const u32x4*)(r3 + vcol);
        }
    }
    static __device__ __forceinline__ void compute(const Frags& f, LAS unsigned char* kw, LAS unsigned char* kwx, const LAS unsigned char* kr, const LAS unsigned char* krx, LAS unsigned char* vw, const LAS unsigned char* (&vr)[4], const LAS float* tb, int Lb, int c, int fq, const bf16x8 (&qf)[2], f32x4 (&oacc)[4], float& mref, float& lrun) {
        const int lbase = Lb - 64 + 32 * c;
        *(LAS u32x4*)(kw) = f.k0; *(LAS u32x4*)(kwx + 8 * 128) = f.k1; *(LAS u32x4*)(kw + 16 * 128) = f.k2; *(LAS u32x4*)(kwx + 24 * 128) = f.k3;
        *(LAS u32x4*)(vw) = f.v0; *(LAS u32x4*)(vw + 8 * 32) = f.v1; *(LAS u32x4*)(vw + 16 * 32) = f.v2; *(LAS u32x4*)(vw + 24 * 32) = f.v3;
        const LAS float* t = tb + 32 * c;
        f32x4 sa = {t[0], t[1], t[2], t[3]}, sb = {t[16], t[17], t[18], t[19]};
        if (!(lbase >= 0 && lbase + 31 < LMAX)) {
            const float NEG = -__builtin_inff();
#pragma unroll
            for (int e = 0; e < 4; ++e) { const int la = lbase + 4 * fq + e, lb2 = la + 16; if (la < 0 || la >= LMAX) sa[e] = NEG; if (lb2 < 0 || lb2 >= LMAX) sb[e] = NEG; }
        }
        const bf16x8 k00 = *(const LAS bf16x8*)kr, k01 = *(const LAS bf16x8*)krx, k10 = *(const LAS bf16x8*)(kr + 16 * 128), k11 = *(const LAS bf16x8*)(krx + 16 * 128);
        sa = __builtin_amdgcn_mfma_f32_16x16x32_bf16(k00, qf[0], sa, 0, 0, 0); sa = __builtin_amdgcn_mfma_f32_16x16x32_bf16(k01, qf[1], sa, 0, 0, 0);
        sb = __builtin_amdgcn_mfma_f32_16x16x32_bf16(k10, qf[0], sb, 0, 0, 0); sb = __builtin_amdgcn_mfma_f32_16x16x32_bf16(k11, qf[1], sb, 0, 0, 0);
        const float lm = __builtin_fmaxf(__builtin_fmaxf(__builtin_fmaxf(sa[0], sa[1]), __builtin_fmaxf(sa[2], sa[3])), __builtin_fmaxf(__builtin_fmaxf(sb[0], sb[1]), __builtin_fmaxf(sb[2], sb[3])));
        if (__any(lm > mref + THR)) {
            float rm = __builtin_fmaxf(lm, __shfl_xor(lm, 16)); rm = __builtin_fmaxf(rm, __shfl_xor(rm, 32));
            const float mnew = __builtin_fmaxf(mref, rm), alpha = __builtin_amdgcn_exp2f(mref - mnew);
            lrun *= alpha;
#pragma unroll
            for (int d = 0; d < 4; ++d) oacc[d] = oacc[d] * alpha;
            mref = mnew;
        }
        float ls = 0.f;
#pragma unroll
        for (int e = 0; e < 4; ++e) { sa[e] = __builtin_amdgcn_exp2f(sa[e] - mref); sb[e] = __builtin_amdgcn_exp2f(sb[e] - mref); ls += sa[e] + sb[e]; }
        lrun += ls;
        u32x4 pw; pw.x = cvtpk(sa[0], sa[1]); pw.y = cvtpk(sa[2], sa[3]); pw.z = cvtpk(sb[0], sb[1]); pw.w = cvtpk(sb[2], sb[3]);
        const bf16x8 pk = __builtin_bit_cast(bf16x8, pw);
#pragma unroll
        for (int d = 0; d < 4; ++d) { const s16x4 lo = tr16(vr[d]), hi = tr16(vr[d] + 512);
            const bf16x8 va = __builtin_shufflevector(lo, hi, 0, 1, 2, 3, 4, 5, 6, 7);
            oacc[d] = __builtin_amdgcn_mfma_f32_16x16x32_bf16(va, pk, oacc[d], 0, 0, 0); }
    }
    template <int NSTEP>
    static __device__ __forceinline__ void run(LAS unsigned char* kw, LAS unsigned char* kwx, const LAS unsigned char* kr, const LAS unsigned char* krx, LAS unsigned char* vw, const LAS unsigned char* (&vr)[4], const LAS float* ext_h, const bf16_t* __restrict__ prow, int t0, int lane, unsigned kcol, unsigned vcol, const bf16x8 (&qf)[2], f32x4 (&oacc)[4], float& mref, float& lrun) {
        const int i16 = lane & 15, fq = lane >> 4, vrow = lane >> 3;
        const int Lb = __builtin_amdgcn_readfirstlane(t0 >> LD), rem = __builtin_amdgcn_readfirstlane(t0 & (D - 1));
        const unsigned offK = (unsigned)(vrow << LD) * ROWB + kcol, offV = (unsigned)(vrow << LD) * ROWB + vcol;
        const LAS float* tb = ext_h + (LD == 4 ? 0 : (LD == 2 ? EXT_OFF1 : EXT_OFF2)) + 15 * QS + 4 * fq - QS * i16;
        Frags A, B;
        load(A, prow, Lb, rem, 0, offK, offV, vrow, kcol, vcol);
        int c = 0;
#pragma unroll 1
        for (; c + 1 < NSTEP; c += 2) {
            load(B, prow, Lb, rem, c + 1, offK, offV, vrow, kcol, vcol);
            compute(A, kw, kwx, kr, krx, vw, vr, tb, Lb, c, fq, qf, oacc, mref, lrun);
            if (c + 2 < NSTEP) load(A, prow, Lb, rem, c + 2, offK, offV, vrow, kcol, vcol);
            compute(B, kw, kwx, kr, krx, vw, vr, tb, Lb, c + 1, fq, qf, oacc, mref, lrun);
        }
        if (NSTEP & 1) compute(A, kw, kwx, kr, krx, vw, vr, tb, Lb, NSTEP - 1, fq, qf, oacc, mref, lrun);
    }
};
constexpr int SH_PITCH = 160, SH_TILE = 40 * SH_PITCH, SH_BUF = 2 * SH_TILE;
template <int DV>
__device__ __forceinline__ void p1_shared(LAS unsigned char* sh, const LAS float* ext_h, const bf16_t* __restrict__ prow, int h, int T, int w, int lane, const bf16x8 (&qf)[2], f32x4 (&oacc)[4], float& mref, float& lrun) {
    constexpr int NSTEP = (DV == 6) ? 6 : 12;
    const int tid = threadIdx.x, i16 = lane & 15, fq = lane >> 4;
    const int r0 = tid >> 4, c0 = tid & 15; const bool two = tid < 128; const int r1 = (tid + 512) >> 4;
    const unsigned col0 = (unsigned)((c0 < 8 ? COL_KA : COL_VA - 64) + 64 * h + 8 * c0) * 2u;
    const int d0 = (c0 < 8 ? 0 : SH_TILE) + r0 * SH_PITCH + (c0 & 7) * 16, d1 = (c0 < 8 ? 0 : SH_TILE) + r1 * SH_PITCH + (c0 & 7) * 16;
    auto ld = [&](int c, int row) { int p = T - 64 + 32 * c + row; p = p < 0 ? 0 : (p > SEQ - 1 ? SEQ - 1 : p); return *(const u32x4*)((const char*)prow + (size_t)p * ROWB + col0); };
    u32x4 ga = ld(0, r0), gb = (u32x4){0u, 0u, 0u, 0u}, ha, hb = (u32x4){0u, 0u, 0u, 0u}; if (two) gb = ld(0, r1);
    __syncthreads();
    *(LAS u32x4*)(sh + d0) = ga; if (two) *(LAS u32x4*)(sh + d1) = gb;
    ga = ld(1, r0); if (two) gb = ld(1, r1);
    ha = ld(2, r0); if (two) hb = ld(2, r1);
    const LAS float* tb = ext_h + EXT_OFF2 + 15 * 16 + 4 * fq - 16 * i16;
    const int kro = (w + i16) * SH_PITCH + fq * 16, vro = SH_TILE + (w + 4 * fq + (i16 >> 2)) * SH_PITCH + (i16 & 3) * 8;
    asm volatile("s_waitcnt lgkmcnt(0)\n\ts_barrier" ::: "memory");
#pragma unroll 1
    for (int c = 0; c < NSTEP; ++c) {
        const LAS unsigned char* bufp = sh + (c & 1) * SH_BUF;
        const int lbase = T + w - 64 + 32 * c;
        const LAS float* t = tb + 32 * c;
        f32x4 sa = {t[0], t[1], t[2], t[3]}, sb = {t[16], t[17], t[18], t[19]};
        if (!(lbase >= 0 && lbase + 31 < SEQ)) { const float NEG = -__builtin_inff();
#pragma unroll
            for (int e = 0; e < 4; ++e) { const int la = lbase + 4 * fq + e, lb2 = la + 16; if (la < 0 || la >= SEQ) sa[e] = NEG; if (lb2 < 0 || lb2 >= SEQ) sb[e] = NEG; } }
        const bf16x8 k00 = *(const LAS bf16x8*)(bufp + kro), k01 = *(const LAS bf16x8*)(bufp + kro + 64), k10 = *(const LAS bf16x8*)(bufp + kro + 16 * SH_PITCH), k11 = *(const LAS bf16x8*)(bufp + kro + 16 * SH_PITCH + 64);
        sa = __builtin_amdgcn_mfma_f32_16x16x32_bf16(k00, qf[0], sa, 0, 0, 0); sa = __builtin_amdgcn_mfma_f32_16x16x32_bf16(k01, qf[1], sa, 0, 0, 0);
        sb = __builtin_amdgcn_mfma_f32_16x16x32_bf16(k10, qf[0], sb, 0, 0, 0); sb = __builtin_amdgcn_mfma_f32_16x16x32_bf16(k11, qf[1], sb, 0, 0, 0);
        if (DV == 5) { lrun += sa[0] + sb[0]; } else {
        const float lm = __builtin_fmaxf(__builtin_fmaxf(__builtin_fmaxf(sa[0], sa[1]), __builtin_fmaxf(sa[2], sa[3])), __builtin_fmaxf(__builtin_fmaxf(sb[0], sb[1]), __builtin_fmaxf(sb[2], sb[3])));
        if (__any(lm > mref + THR)) {
            float rm = __builtin_fmaxf(lm, __shfl_xor(lm, 16)); rm = __builtin_fmaxf(rm, __shfl_xor(rm, 32));
            const float mnew = __builtin_fmaxf(mref, rm), alpha = __builtin_amdgcn_exp2f(mref - mnew);
            lrun *= alpha;
#pragma unroll
            for (int d = 0; d < 4; ++d) oacc[d] = oacc[d] * alpha;
            mref = mnew;
        }
        float ls = 0.f;
#pragma unroll
        for (int e = 0; e < 4; ++e) { sa[e] = __builtin_amdgcn_exp2f(sa[e] - mref); sb[e] = __builtin_amdgcn_exp2f(sb[e] - mref); ls += sa[e] + sb[e]; }
        lrun += ls;
        u32x4 pw; pw.x = cvtpk(sa[0], sa[1]); pw.y = cvtpk(sa[2], sa[3]); pw.z = cvtpk(sb[0], sb[1]); pw.w = cvtpk(sb[2], sb[3]);
        const bf16x8 pk = __builtin_bit_cast(bf16x8, pw);
#pragma unroll
        for (int d = 0; d < 4; ++d) { const s16x4 lo = tr16(bufp + vro + d * 32), hi = tr16(bufp + vro + d * 32 + 16 * SH_PITCH);
            const bf16x8 va = __builtin_shufflevector(lo, hi, 0, 1, 2, 3, 4, 5, 6, 7);
            oacc[d] = __builtin_amdgcn_mfma_f32_16x16x32_bf16(va, pk, oacc[d], 0, 0, 0); }
        }
        if (DV != 4 && c + 1 < NSTEP) { LAS unsigned char* nb = sh + ((c + 1) & 1) * SH_BUF; *(LAS u32x4*)(nb + d0) = ga; if (two) *(LAS u32x4*)(nb + d1) = gb;
            ga = ha; gb = hb; const int cn = c + 3 < NSTEP ? c + 3 : NSTEP - 1; ha = ld(cn, r0); if (two) hb = ld(cn, r1); }
        if (DV != 4) asm volatile("s_waitcnt lgkmcnt(0)\n\ts_barrier" ::: "memory");
    }
}
template <bool SHARED, int DV>
__device__ __forceinline__ void item(LAS unsigned char* vst, const LAS float* ext, LAS unsigned char* sh, int wv, int b, int h, int blk, int r, const bf16_t* __restrict__ proj, bf16_t* __restrict__ O, int lane) {
    const int i16 = lane & 15, fq = lane >> 4, t0 = 256 * blk + r, vrow = lane >> 3, vch = lane & 7;
    const bf16_t* prow = proj + (size_t)b * SEQ * NPROJ;
    const int qpos = t0 + 16 * i16;
    const bf16_t* qp = prow + (size_t)qpos * NPROJ + COL_QA + 64 * h + 8 * fq;
    bf16x8 qf[2]; qf[0] = *(const bf16x8*)qp; qf[1] = *(const bf16x8*)(qp + 32);
    const unsigned kcol = (unsigned)(COL_KA + 64 * h + 8 * vch) * 2u, vcol = (unsigned)(COL_VA + 64 * h + 8 * vch) * 2u;
    LAS unsigned char* ktile = vst + 4096;
    LAS unsigned char* kw = ktile + vrow * 128 + ((vch ^ ((vrow >> 1) & 7)) * 16); LAS unsigned char* kwx = ktile + vrow * 128 + ((vch ^ ((vrow >> 1) & 7) ^ 4) * 16);
    const LAS unsigned char* kr = ktile + i16 * 128 + ((fq ^ ((i16 >> 1) & 7)) * 16); const LAS unsigned char* krx = ktile + i16 * 128 + (((fq + 4) ^ ((i16 >> 1) & 7)) * 16);
    LAS unsigned char* vw = vst + (vch >> 1) * 1024 + ((vrow ^ (vch >> 1)) * 32) + (vch & 1) * 16;
    const LAS unsigned char* vr[4];
#pragma unroll
    for (int d = 0; d < 4; ++d) vr[d] = vst + d * 1024 + (4 * fq + ((i16 >> 2) ^ d)) * 32 + (i16 & 3) * 8;
    f32x4 oacc[4];
#pragma unroll
    for (int d = 0; d < 4; ++d) oacc[d] = (f32x4){0.f, 0.f, 0.f, 0.f};
    float mref = -1.0e30f, lrun = 0.f;
    const LAS float* ext_h = ext + h * EXT_H;
    if (DV == 0 || DV == 1) Pat<4>::run<5>(kw, kwx, kr, krx, vw, vr, ext_h, prow, t0, lane, kcol, vcol, qf, oacc, mref, lrun);
    if (DV == 0 || DV == 1) Pat<2>::run<6>(kw, kwx, kr, krx, vw, vr, ext_h, prow, t0, lane, kcol, vcol, qf, oacc, mref, lrun);
    if (DV == 1 || DV == 3) {} else if (SHARED) p1_shared<DV>(sh, ext_h, prow, h, t0 - wv, wv, lane, qf, oacc, mref, lrun);
    else Pat<0>::run<12>(kw, kwx, kr, krx, vw, vr, ext_h, prow, t0, lane, kcol, vcol, qf, oacc, mref, lrun);
    lrun = pg8::fq_sum(lrun);
    const float inv = 1.f / lrun;
    bf16_t* op = O + ((size_t)b * SEQ + qpos) * DM + 64 * h + 4 * fq;
#pragma unroll
    for (int d = 0; d < 4; ++d) { u32x2 w; w.x = cvtpk(oacc[d][0] * inv, oacc[d][1] * inv); w.y = cvtpk(oacc[d][2] * inv, oacc[d][3] * inv); *(u32x2*)(op + 16 * d) = w; }
}
}

namespace dil2 {
using dil::Frags; using dil::EXT_OFF1; using dil::EXT_OFF2; using dil::EXT_H; using dil::THR; using dil::ROWB;
constexpr int WTILE = 16384;
constexpr int SH_PITCH = 160, SH_ROWS = 48, SH_TILE = SH_ROWS * SH_PITCH, SH_BUF = 2 * SH_TILE;
struct St { bf16x8 q0, q1; f32x4 o0, o1, o2, o3; float mref, lrun; };
constexpr int T2_OFF1 = 176, T2_OFFC = 428, T2_H = 604;
__device__ __forceinline__ void build_ext_all(LAS float* ext4, const float* __restrict__ rel_bias, int hpar) {
    for (int idx = threadIdx.x; idx < 4 * T2_H; idx += NTHREADS) { const int i = idx / T2_H, k = idx % T2_H, h = 2 * i + hpar; int d, j;
        if (k < T2_OFF1) { d = 16; j = k - 79; } else if (k < T2_OFFC) { d = 4; j = k - T2_OFF1 - 124; } else { d = 1; j = k - T2_OFFC - 79; }
        ext4[idx] = (j >= -64 && j <= 64) ? rel_bias[t5_bucket(d * j) * 8 + h] * LOG2E : -__builtin_inff(); }
}
__device__ __forceinline__ void build_ext_h(LAS float* ext, const float* __restrict__ rel_bias, int h) {
    for (int k = threadIdx.x; k < EXT_H + 176; k += NTHREADS) { int d, j; if (k < EXT_OFF1) { d = 16; j = k - 79; } else if (k < EXT_OFF2) { d = 4; j = k - EXT_OFF1 - 124; } else if (k < EXT_H) { d = 1; j = k - EXT_OFF2 - 304; } else { d = 1; j = k - EXT_H - 79; }
        ext[k] = (j >= -64 && j <= 64) ? rel_bias[t5_bucket(d * j) * 8 + h] * LOG2E : -__builtin_inff(); }
}
__device__ __forceinline__ float lanemax8(const f32x4 a, const f32x4 b) { return __builtin_fmaxf(__builtin_fmaxf(__builtin_fmaxf(a[0], a[1]), __builtin_fmaxf(a[2], a[3])), __builtin_fmaxf(__builtin_fmaxf(b[0], b[1]), __builtin_fmaxf(b[2], b[3]))); }
__device__ __forceinline__ void refresh(St& s, float lm) {
    float rm = __builtin_fmaxf(lm, __shfl_xor(lm, 16)); rm = __builtin_fmaxf(rm, __shfl_xor(rm, 32));
    const float mnew = __builtin_fmaxf(s.mref, rm), alpha = __builtin_amdgcn_exp2f(s.mref - mnew);
    s.lrun *= alpha; s.o0 = s.o0 * alpha; s.o1 = s.o1 * alpha; s.o2 = s.o2 * alpha; s.o3 = s.o3 * alpha; s.mref = mnew;
}
#ifndef DIL2_EXP
#define DIL2_EXP(x) __builtin_amdgcn_exp2f(x)
#endif
__device__ __forceinline__ bf16x8 expsum(St& s, f32x4 sa, f32x4 sb) {
    float ls = 0.f;
#pragma unroll
    for (int e = 0; e < 4; ++e) { sa[e] = DIL2_EXP(sa[e] - s.mref); sb[e] = DIL2_EXP(sb[e] - s.mref); ls += sa[e] + sb[e]; }
    s.lrun += ls;
    u32x4 pw; pw.x = cvtpk(sa[0], sa[1]); pw.y = cvtpk(sa[2], sa[3]); pw.z = cvtpk(sb[0], sb[1]); pw.w = cvtpk(sb[2], sb[3]);
    return __builtin_bit_cast(bf16x8, pw);
}
__device__ __forceinline__ void maskrows(f32x4& sa, f32x4& sb, int lbase, int fq, int lmax) {
    const float NEG = -__builtin_inff();
#pragma unroll
    for (int e = 0; e < 4; ++e) { const int la = lbase + 4 * fq + e, lb2 = la + 16; if (la < 0 || la >= lmax) sa[e] = NEG; if (lb2 < 0 || lb2 >= lmax) sb[e] = NEG; }
}
#define MF16(a, b, c) __builtin_amdgcn_mfma_f32_16x16x32_bf16((a), (b), (c), 0, 0, 0)
#define VFR(p) __builtin_shufflevector(tr16(p), tr16((p) + VHI), 0, 1, 2, 3, 4, 5, 6, 7)
__device__ __forceinline__ void soft2(St& A, St& B, f32x4 sa0, f32x4 sb0, f32x4 sa1, f32x4 sb1, bf16x8& pkA, bf16x8& pkB) {
    const float lmA = lanemax8(sa0, sb0), lmB = lanemax8(sa1, sb1);
    if (__any((lmA > A.mref + THR) || (lmB > B.mref + THR))) { refresh(A, lmA); refresh(B, lmB); }
    pkA = expsum(A, sa0, sb0); pkB = expsum(B, sa1, sb1);
}
struct Addr { LAS unsigned char *kw, *kwx, *vw; const LAS unsigned char *kr, *krx, *vr0, *vr1, *vr2, *vr3; };
template <int LD>
struct Pat2 {
    static constexpr int D = 1 << LD, QS = 16 >> LD, LMAX = SEQ >> LD, DB = 8 >> LD, REMB = (LD == 4) ? 8 : 0;
    static __device__ __forceinline__ void load(Frags& fa, Frags& fb, const bf16_t* __restrict__ prow, int Lb, int rem, int c, unsigned offK, unsigned offV, int vrow, unsigned kcol, unsigned vcol) {
        const int lbase = Lb - 64 + 32 * c;
        constexpr size_t R8 = (size_t)(8 << LD) * ROWB;
        if (lbase >= 0 && lbase + DB + 31 < LMAX) {
            const char* ua = (const char*)prow + (size_t)((lbase << LD) + rem) * ROWB; const char* ub = ua + 8 * ROWB;
            fa.k0 = *(const u32x4*)(ua + offK); fa.k1 = *(const u32x4*)(ua + offK + R8); fa.k2 = *(const u32x4*)(ua + offK + 2 * R8); fa.k3 = *(const u32x4*)(ua + offK + 3 * R8);
            fa.v0 = *(const u32x4*)(ua + offV); fa.v1 = *(const u32x4*)(ua + offV + R8); fa.v2 = *(const u32x4*)(ua + offV + 2 * R8); fa.v3 = *(const u32x4*)(ua + offV + 3 * R8);
            fb.k0 = *(const u32x4*)(ub + offK); fb.k1 = *(const u32x4*)(ub + offK + R8); fb.k2 = *(const u32x4*)(ub + offK + 2 * R8); fb.k3 = *(const u32x4*)(ub + offK + 3 * R8);
            fb.v0 = *(const u32x4*)(ub + offV); fb.v1 = *(const u32x4*)(ub + offV + R8); fb.v2 = *(const u32x4*)(ub + offV + 2 * R8); fb.v3 = *(const u32x4*)(ub + offV + 3 * R8);
        } else {
            auto rowp = [&](int l, int rm) { l = l < 0 ? 0 : (l > LMAX - 1 ? LMAX - 1 : l); return (const char*)prow + (size_t)((l << LD) + rm) * ROWB; };
            { const char* r0 = rowp(lbase + vrow, rem); const char* r1 = rowp(lbase + vrow + 8, rem); const char* r2 = rowp(lbase + vrow + 16, rem); const char* r3 = rowp(lbase + vrow + 24, rem);
              fa.k0 = *(const u32x4*)(r0 + kcol); fa.k1 = *(const u32x4*)(r1 + kcol); fa.k2 = *(const u32x4*)(r2 + kcol); fa.k3 = *(const u32x4*)(r3 + kcol);
              fa.v0 = *(const u32x4*)(r0 + vcol); fa.v1 = *(const u32x4*)(r1 + vcol); fa.v2 = *(const u32x4*)(r2 + vcol); fa.v3 = *(const u32x4*)(r3 + vcol); }
            { const int lb = lbase + DB, rb = rem + REMB;
              const char* r0 = rowp(lb + vrow, rb); const char* r1 = rowp(lb + vrow + 8, rb); const char* r2 = rowp(lb + vrow + 16, rb); const char* r3 = rowp(lb + vrow + 24, rb);
              fb.k0 = *(const u32x4*)(r0 + kcol); fb.k1 = *(const u32x4*)(r1 + kcol); fb.k2 = *(const u32x4*)(r2 + kcol); fb.k3 = *(const u32x4*)(r3 + kcol);
              fb.v0 = *(const u32x4*)(r0 + vcol); fb.v1 = *(const u32x4*)(r1 + vcol); fb.v2 = *(const u32x4*)(r2 + vcol); fb.v3 = *(const u32x4*)(r3 + vcol); }
        }
    }
    static __device__ __forceinline__ void stage(const Frags& fa, const Frags& fb, const Addr& a) {
        constexpr int BO = 8192;
        *(LAS u32x4*)(a.kw) = fa.k0; *(LAS u32x4*)(a.kwx + 8 * 128) = fa.k1; *(LAS u32x4*)(a.kw + 16 * 128) = fa.k2; *(LAS u32x4*)(a.kwx + 24 * 128) = fa.k3;
        *(LAS u32x4*)(a.kw + BO) = fb.k0; *(LAS u32x4*)(a.kwx + BO + 8 * 128) = fb.k1; *(LAS u32x4*)(a.kw + BO + 16 * 128) = fb.k2; *(LAS u32x4*)(a.kwx + BO + 24 * 128) = fb.k3;
        *(LAS u32x4*)(a.vw) = fa.v0; *(LAS u32x4*)(a.vw + 8 * 32) = fa.v1; *(LAS u32x4*)(a.vw + 16 * 32) = fa.v2; *(LAS u32x4*)(a.vw + 24 * 32) = fa.v3;
        *(LAS u32x4*)(a.vw + BO) = fb.v0; *(LAS u32x4*)(a.vw + BO + 8 * 32) = fb.v1; *(LAS u32x4*)(a.vw + BO + 16 * 32) = fb.v2; *(LAS u32x4*)(a.vw + BO + 24 * 32) = fb.v3;
    }
    static __device__ __forceinline__ void core(const Addr& a, const LAS float* tb, int Lb, int c, int fq, St& A, St& B) {
        constexpr int BO = 8192, VHI = 512;
        const int lbase = Lb - 64 + 32 * c;
        const LAS float* t = tb + 32 * c;
        f32x4 sa0 = {t[0], t[1], t[2], t[3]}, sb0 = {t[16], t[17], t[18], t[19]}, sa1 = sa0, sb1 = sb0;
        if (!(lbase >= 0 && lbase + DB + 31 < LMAX)) { maskrows(sa0, sb0, lbase, fq, LMAX); maskrows(sa1, sb1, lbase + DB, fq, LMAX); }
        { const bf16x8 k00 = *(const LAS bf16x8*)a.kr, k01 = *(const LAS bf16x8*)a.krx, k10 = *(const LAS bf16x8*)(a.kr + 16 * 128), k11 = *(const LAS bf16x8*)(a.krx + 16 * 128);
          const bf16x8 j00 = *(const LAS bf16x8*)(a.kr + BO), j01 = *(const LAS bf16x8*)(a.krx + BO), j10 = *(const LAS bf16x8*)(a.kr + BO + 16 * 128), j11 = *(const LAS bf16x8*)(a.krx + BO + 16 * 128);
          sa0 = MF16(k00, A.q0, sa0); sa1 = MF16(j00, B.q0, sa1); sb0 = MF16(k10, A.q0, sb0); sb1 = MF16(j10, B.q0, sb1);
          sa0 = MF16(k01, A.q1, sa0); sa1 = MF16(j01, B.q1, sa1); sb0 = MF16(k11, A.q1, sb0); sb1 = MF16(j11, B.q1, sb1); }
        bf16x8 va0 = VFR(a.vr0), vb0 = VFR(a.vr0 + BO), va1 = VFR(a.vr1), vb1 = VFR(a.vr1 + BO), va2 = VFR(a.vr2), vb2 = VFR(a.vr2 + BO), va3 = VFR(a.vr3), vb3 = VFR(a.vr3 + BO);
        __builtin_amdgcn_sched_barrier(0);
        bf16x8 pkA, pkB; soft2(A, B, sa0, sb0, sa1, sb1, pkA, pkB);
        asm volatile("" : "+v"(va0), "+v"(vb0), "+v"(va1), "+v"(vb1), "+v"(va2), "+v"(vb2), "+v"(va3), "+v"(vb3));
        A.o0 = MF16(va0, pkA, A.o0); B.o0 = MF16(vb0, pkB, B.o0); A.o1 = MF16(va1, pkA, A.o1); B.o1 = MF16(vb1, pkB, B.o1);
        A.o2 = MF16(va2, pkA, A.o2); B.o2 = MF16(vb2, pkB, B.o2); A.o3 = MF16(va3, pkA, A.o3); B.o3 = MF16(vb3, pkB, B.o3);
    }
    static __device__ __forceinline__ void first(Frags& fa, Frags& fb, const bf16_t* __restrict__ prow, int t0, int lane, unsigned kcol, unsigned vcol) {
        const int vrow = lane >> 3;
        const int Lb = __builtin_amdgcn_readfirstlane(t0 >> LD), rem = __builtin_amdgcn_readfirstlane(t0 & (D - 1));
        const unsigned offK = (unsigned)(vrow << LD) * ROWB + kcol, offV = (unsigned)(vrow << LD) * ROWB + vcol;
        load(fa, fb, prow, Lb, rem, 0, offK, offV, vrow, kcol, vcol);
    }
    template <int NSTEP>
    static __device__ __forceinline__ void run(const Addr& a, const LAS float* ext_h, const bf16_t* __restrict__ prow, int t0, int lane, unsigned kcol, unsigned vcol, St& A, St& B, Frags& fa, Frags& fb) {
        const int i16 = lane & 15, fq = lane >> 4, vrow = lane >> 3;
        const int Lb = __builtin_amdgcn_readfirstlane(t0 >> LD), rem = __builtin_amdgcn_readfirstlane(t0 & (D - 1));
        const unsigned offK = (unsigned)(vrow << LD) * ROWB + kcol, offV = (unsigned)(vrow << LD) * ROWB + vcol;
        const LAS float* tb = ext_h + (LD == 4 ? 0 : T2_OFF1) + 15 * QS + 4 * fq - QS * i16;
#pragma unroll 1
        for (int c = 0; c < NSTEP; ++c) {
            stage(fa, fb, a);
            if (c + 1 < NSTEP) load(fa, fb, prow, Lb, rem, c + 1, offK, offV, vrow, kcol, vcol);
            core(a, tb, Lb, c, fq, A, B);
        }
    }
};
__device__ __forceinline__ void p1_shared(LAS unsigned char* sh, const LAS float* ext_h, const bf16_t* __restrict__ prow, int h, int T, int w, int lane, St& A, St& B) {
    constexpr int NSTEP = 12, VHI = 16 * SH_PITCH;
    const int tid = threadIdx.x, i16 = lane & 15, fq = lane >> 4;
    const int r0 = tid >> 4, c0 = tid & 15; const bool two = tid < 256; const int r1 = 32 + r0;
    const unsigned col0 = (unsigned)((c0 < 8 ? COL_KA : COL_VA - 64) + 64 * h + 8 * c0) * 2u;
    const int d0 = (c0 < 8 ? 0 : SH_TILE) + r0 * SH_PITCH + (c0 & 7) * 16, d1 = d0 + 32 * SH_PITCH;
    auto ld = [&](int c, int row) { int p = T - 64 + 32 * c + row; p = p < 0 ? 0 : (p > SEQ - 1 ? SEQ - 1 : p); return *(const u32x4*)((const char*)prow + (size_t)p * ROWB + col0); };
    u32x4 ga = ld(0, r0), gb = (u32x4){0u, 0u, 0u, 0u}, ha, hb = (u32x4){0u, 0u, 0u, 0u}; if (two) gb = ld(0, r1);
    __syncthreads();
    *(LAS u32x4*)(sh + d0) = ga; if (two) *(LAS u32x4*)(sh + d1) = gb;
    ga = ld(1, r0); if (two) gb = ld(1, r1);
    ha = ld(2, r0); if (two) hb = ld(2, r1);
    const LAS float* tb = ext_h + EXT_OFF2 + 15 * 16 + 4 * fq - 16 * i16;
    const int kro = (w + i16) * SH_PITCH + fq * 16, vro = SH_TILE + (w + 4 * fq + (i16 >> 2)) * SH_PITCH + (i16 & 3) * 8;
    constexpr int BO = 8 * SH_PITCH;
    asm volatile("s_waitcnt lgkmcnt(0)\n\ts_barrier" ::: "memory");
#pragma unroll 1
    for (int c = 0; c < NSTEP; ++c) {
        const LAS unsigned char* bufp = sh + (c & 1) * SH_BUF;
        const int lbase = T + w - 64 + 32 * c;
        const LAS float* t = tb + 32 * c;
        f32x4 sa0 = {t[0], t[1], t[2], t[3]}, sb0 = {t[16], t[17], t[18], t[19]}, sa1 = sa0, sb1 = sb0;
        if (!(lbase >= 0 && lbase + 8 + 31 < SEQ)) { maskrows(sa0, sb0, lbase, fq, SEQ); maskrows(sa1, sb1, lbase + 8, fq, SEQ); }
        { const LAS unsigned char* kp = bufp + kro;
          const bf16x8 k00 = *(const LAS bf16x8*)kp, k01 = *(const LAS bf16x8*)(kp + 64), k10 = *(const LAS bf16x8*)(kp + 16 * SH_PITCH), k11 = *(const LAS bf16x8*)(kp + 16 * SH_PITCH + 64);
          const bf16x8 j00 = *(const LAS bf16x8*)(kp + BO), j01 = *(const LAS bf16x8*)(kp + BO + 64), j10 = *(const LAS bf16x8*)(kp + BO + 16 * SH_PITCH), j11 = *(const LAS bf16x8*)(kp + BO + 16 * SH_PITCH + 64);
          sa0 = MF16(k00, A.q0, sa0); sa1 = MF16(j00, B.q0, sa1); sb0 = MF16(k10, A.q0, sb0); sb1 = MF16(j10, B.q0, sb1);
          sa0 = MF16(k01, A.q1, sa0); sa1 = MF16(j01, B.q1, sa1); sb0 = MF16(k11, A.q1, sb0); sb1 = MF16(j11, B.q1, sb1); }
        bf16x8 pkA, pkB; soft2(A, B, sa0, sb0, sa1, sb1, pkA, pkB);
        { const LAS unsigned char* vp = bufp + vro;
          A.o0 = MF16(VFR(vp), pkA, A.o0); B.o0 = MF16(VFR(vp + BO), pkB, B.o0); A.o1 = MF16(VFR(vp + 32), pkA, A.o1); B.o1 = MF16(VFR(vp + BO + 32), pkB, B.o1);
          A.o2 = MF16(VFR(vp + 64), pkA, A.o2); B.o2 = MF16(VFR(vp + BO + 64), pkB, B.o2); A.o3 = MF16(VFR(vp + 96), pkA, A.o3); B.o3 = MF16(VFR(vp + BO + 96), pkB, B.o3); }
        if (c + 1 < NSTEP) { LAS unsigned char* nb = sh + ((c + 1) & 1) * SH_BUF; *(LAS u32x4*)(nb + d0) = ga; if (two) *(LAS u32x4*)(nb + d1) = gb;
            ga = ha; gb = hb; const int cn = c + 3 < NSTEP ? c + 3 : NSTEP - 1; ha = ld(cn, r0); if (two) hb = ld(cn, r1); }
        asm volatile("s_waitcnt lgkmcnt(0)\n\ts_barrier" ::: "memory");
    }
}
constexpr int XP = 272, X_M = 272 * XP, X_L = X_M + 1088, IMG_ROWS = 400, IMG_V = IMG_ROWS * SH_PITCH;
__device__ __forceinline__ void p1_consec(LAS unsigned char* lds, const LAS float* ext_h, const bf16_t* __restrict__ prow, int h, int T, int w, int lane, St& A, St& B) {
    constexpr int VHI = 16 * SH_PITCH, BO = 16 * SH_PITCH;
    const int tid = fresh_tid(), i16 = tid & 15, fq = (tid & 63) >> 4;
    (void)lane;
    const int c0 = tid & 15, rb = tid >> 4;
    const unsigned col0 = (unsigned)((c0 < 8 ? COL_KA : COL_VA - 64) + 64 * h + 8 * c0) * 2u;
    const int dbase = (c0 < 8 ? 0 : IMG_V) + rb * SH_PITCH + (c0 & 7) * 16;
    auto ld = [&](int k) { int p = T - 64 + rb + 32 * k; p = p < 0 ? 0 : (p > SEQ - 1 ? SEQ - 1 : p); return *(const u32x4*)((const char*)prow + (size_t)p * ROWB + col0); };
    u32x4 g0 = ld(0), g1 = ld(1), g2 = ld(2), g3 = ld(3), g4 = ld(4), g5 = ld(5), g6 = ld(6), g7 = ld(7), g8 = ld(8), g9 = ld(9), g10 = ld(10), g11 = ld(11), g12 = (u32x4){0u, 0u, 0u, 0u};
    if (tid < 256) g12 = ld(12);
    bf16x8 nq0, nq1, nq2, nq3;
    { const bf16_t* qp = prow + (size_t)(T + 32 * w + i16) * NPROJ + COL_QA + 64 * h + 8 * fq;
      nq0 = *(const bf16x8*)qp; nq1 = *(const bf16x8*)(qp + 32); nq2 = *(const bf16x8*)(qp + 16 * NPROJ); nq3 = *(const bf16x8*)(qp + 16 * NPROJ + 32); }
    __syncthreads();
    {
        LAS unsigned char* xa = lds + (w * 17 + i16) * XP + fq * 16; LAS unsigned char* xb = lds + ((w + 8) * 17 + i16) * XP + fq * 16;
        *(LAS f32x4*)(xa) = A.o0; *(LAS f32x4*)(xa + 64) = A.o1; *(LAS f32x4*)(xa + 128) = A.o2; *(LAS f32x4*)(xa + 192) = A.o3;
        *(LAS f32x4*)(xb) = B.o0; *(LAS f32x4*)(xb + 64) = B.o1; *(LAS f32x4*)(xb + 128) = B.o2; *(LAS f32x4*)(xb + 192) = B.o3;
        LAS float* M = (LAS float*)(lds + X_M); LAS float* L = (LAS float*)(lds + X_L);
        const int sa = w * 17 + i16, sb = (w + 8) * 17 + i16;
        if (fq == 0) { M[sa] = A.mref; M[sb] = B.mref; }
        L[sa * 4 + fq] = A.lrun; L[sb * 4 + fq] = B.lrun;
    }
    asm volatile("s_waitcnt lgkmcnt(0)\n\ts_barrier" ::: "memory");
    {
        const int sa = i16 * 17 + 2 * w, sb = sa + 1;
        const LAS unsigned char* xa = lds + sa * XP + fq * 16; const LAS unsigned char* xb = lds + sb * XP + fq * 16;
        A.o0 = *(const LAS f32x4*)(xa); A.o1 = *(const LAS f32x4*)(xa + 64); A.o2 = *(const LAS f32x4*)(xa + 128); A.o3 = *(const LAS f32x4*)(xa + 192);
        B.o0 = *(const LAS f32x4*)(xb); B.o1 = *(const LAS f32x4*)(xb + 64); B.o2 = *(const LAS f32x4*)(xb + 128); B.o3 = *(const LAS f32x4*)(xb + 192);
        const LAS float* M = (const LAS float*)(lds + X_M); const LAS float* L = (const LAS float*)(lds + X_L);
        A.mref = M[sa]; B.mref = M[sb]; A.lrun = L[sa * 4 + fq]; B.lrun = L[sb * 4 + fq];
        A.q0 = nq0; A.q1 = nq1; B.q0 = nq2; B.q1 = nq3;
    }
    asm volatile("s_waitcnt lgkmcnt(0)\n\ts_barrier" ::: "memory");
    *(LAS u32x4*)(lds + dbase) = g0; *(LAS u32x4*)(lds + dbase + 32 * SH_PITCH) = g1; *(LAS u32x4*)(lds + dbase + 64 * SH_PITCH) = g2; *(LAS u32x4*)(lds + dbase + 96 * SH_PITCH) = g3;
    *(LAS u32x4*)(lds + dbase + 128 * SH_PITCH) = g4; *(LAS u32x4*)(lds + dbase + 160 * SH_PITCH) = g5; *(LAS u32x4*)(lds + dbase + 192 * SH_PITCH) = g6;
    *(LAS u32x4*)(lds + dbase + 224 * SH_PITCH) = g7; *(LAS u32x4*)(lds + dbase + 256 * SH_PITCH) = g8; *(LAS u32x4*)(lds + dbase + 288 * SH_PITCH) = g9; *(LAS u32x4*)(lds + dbase + 320 * SH_PITCH) = g10;
    *(LAS u32x4*)(lds + dbase + 352 * SH_PITCH) = g11; if (tid < 256) *(LAS u32x4*)(lds + dbase + 384 * SH_PITCH) = g12;
    asm volatile("s_waitcnt lgkmcnt(0)\n\ts_barrier" ::: "memory");
    const LAS float* tb = ext_h + T2_OFFC + 15 + 4 * fq - i16;
    const int kro = (32 * w + i16) * SH_PITCH + fq * 16, vro = IMG_V + (32 * w + 4 * fq + (i16 >> 2)) * SH_PITCH + (i16 & 3) * 8;
#pragma unroll 1
    for (int c = 0; c < 5; ++c) {
        const int lbase = T + 32 * w - 64 + 32 * c;
        const LAS float* t = tb + 32 * c;
        f32x4 sa0 = {t[0], t[1], t[2], t[3]}, sb0 = {t[16], t[17], t[18], t[19]}, sa1 = sa0, sb1 = sb0;
        if (!(lbase >= 0 && lbase + 16 + 31 < SEQ)) { maskrows(sa0, sb0, lbase, fq, SEQ); maskrows(sa1, sb1, lbase + 16, fq, SEQ); }
        { const LAS unsigned char* kp = lds + kro + 32 * c * SH_PITCH;
          const bf16x8 k00 = *(const LAS bf16x8*)kp, k01 = *(const LAS bf16x8*)(kp + 64), k10 = *(const LAS bf16x8*)(kp + 16 * SH_PITCH), k11 = *(const LAS bf16x8*)(kp + 16 * SH_PITCH + 64);
          const bf16x8 j10 = *(const LAS bf16x8*)(kp + 32 * SH_PITCH), j11 = *(const LAS bf16x8*)(kp + 32 * SH_PITCH + 64);
          sa0 = MF16(k00, A.q0, sa0); sa1 = MF16(k10, B.q0, sa1); sb0 = MF16(k10, A.q0, sb0); sb1 = MF16(j10, B.q0, sb1);
          sa0 = MF16(k01, A.q1, sa0); sa1 = MF16(k11, B.q1, sa1); sb0 = MF16(k11, A.q1, sb0); sb1 = MF16(j11, B.q1, sb1); }
        const LAS unsigned char* vp = lds + vro + 32 * c * SH_PITCH;
        bf16x8 va0 = VFR(vp), vb0 = VFR(vp + BO), va1 = VFR(vp + 32), vb1 = VFR(vp + BO + 32), va2 = VFR(vp + 64), vb2 = VFR(vp + BO + 64), va3 = VFR(vp + 96), vb3 = VFR(vp + BO + 96);
        __builtin_amdgcn_sched_barrier(0);
        bf16x8 pkA, pkB; soft2(A, B, sa0, sb0, sa1, sb1, pkA, pkB);
        asm volatile("" : "+v"(va0), "+v"(vb0), "+v"(va1), "+v"(vb1), "+v"(va2), "+v"(vb2), "+v"(va3), "+v"(vb3));
        A.o0 = MF16(va0, pkA, A.o0); B.o0 = MF16(vb0, pkB, B.o0); A.o1 = MF16(va1, pkA, A.o1); B.o1 = MF16(vb1, pkB, B.o1);
        A.o2 = MF16(va2, pkA, A.o2); B.o2 = MF16(vb2, pkB, B.o2); A.o3 = MF16(va3, pkA, A.o3); B.o3 = MF16(vb3, pkB, B.o3);
    }
    asm volatile("s_waitcnt lgkmcnt(0)\n\ts_barrier" ::: "memory");
}
__device__ __forceinline__ void store_item(const St& s, bf16_t* __restrict__ O, size_t row, int h, int fq) {
    const float l = pg8::fq_sum(s.lrun), inv = 1.f / l;
    bf16_t* op = O + row * DM + 64 * h + 4 * fq;
    u32x2 w; w.x = cvtpk(s.o0[0] * inv, s.o0[1] * inv); w.y = cvtpk(s.o0[2] * inv, s.o0[3] * inv); *(u32x2*)(op) = w;
    w.x = cvtpk(s.o1[0] * inv, s.o1[1] * inv); w.y = cvtpk(s.o1[2] * inv, s.o1[3] * inv); *(u32x2*)(op + 16) = w;
    w.x = cvtpk(s.o2[0] * inv, s.o2[1] * inv); w.y = cvtpk(s.o2[2] * inv, s.o2[3] * inv); *(u32x2*)(op + 32) = w;
    w.x = cvtpk(s.o3[0] * inv, s.o3[1] * inv); w.y = cvtpk(s.o3[2] * inv, s.o3[3] * inv); *(u32x2*)(op + 48) = w;
}
struct Pre { Frags fa, fb; bf16x8 q0, q1, q2, q3; };
template <int DV>
__device__ __forceinline__ void round(LAS unsigned char* lds, const LAS float* ext_h, int b, int h, int blk, int w, const bf16_t* __restrict__ proj, bf16_t* __restrict__ O, int lane, Pre& pre, bool first, bool has_next) {
    const int i16 = lane & 15, fq = lane >> 4, vrow = lane >> 3, vch = lane & 7, t0 = 256 * blk + w;
    const bf16_t* prow = proj + (size_t)b * SEQ * NPROJ;
    St A, B;
    const bf16_t* qp = prow + (size_t)(t0 + 16 * i16) * NPROJ + COL_QA + 64 * h + 8 * fq;
    if (first) { pre.q0 = *(const bf16x8*)qp; pre.q1 = *(const bf16x8*)(qp + 32); pre.q2 = *(const bf16x8*)(qp + 8 * NPROJ); pre.q3 = *(const bf16x8*)(qp + 8 * NPROJ + 32); }
    A.q0 = pre.q0; A.q1 = pre.q1; B.q0 = pre.q2; B.q1 = pre.q3;
    A.o0 = A.o1 = A.o2 = A.o3 = B.o0 = B.o1 = B.o2 = B.o3 = (f32x4){0.f, 0.f, 0.f, 0.f}; A.mref = B.mref = -1.0e30f; A.lrun = B.lrun = 0.f;
    const unsigned kcol = (unsigned)(COL_KA + 64 * h + 8 * vch) * 2u, vcol = (unsigned)(COL_VA + 64 * h + 8 * vch) * 2u;
    LAS unsigned char* vst = lds + w * WTILE; LAS unsigned char* ktile = vst + 4096;
    Addr a;
    a.kw = ktile + vrow * 128 + ((vch ^ ((vrow >> 1) & 7)) * 16); a.kwx = ktile + vrow * 128 + ((vch ^ ((vrow >> 1) & 7) ^ 4) * 16);
    a.kr = ktile + i16 * 128 + ((fq ^ ((i16 >> 1) & 7)) * 16); a.krx = ktile + i16 * 128 + (((fq + 4) ^ ((i16 >> 1) & 7)) * 16);
    a.vw = vst + (vch >> 1) * 1024 + ((vrow ^ (vch >> 1)) * 32) + (vch & 1) * 16;
    a.vr0 = vst + 0 * 1024 + (4 * fq + ((i16 >> 2) ^ 0)) * 32 + (i16 & 3) * 8; a.vr1 = vst + 1 * 1024 + (4 * fq + ((i16 >> 2) ^ 1)) * 32 + (i16 & 3) * 8;
    a.vr2 = vst + 2 * 1024 + (4 * fq + ((i16 >> 2) ^ 2)) * 32 + (i16 & 3) * 8; a.vr3 = vst + 3 * 1024 + (4 * fq + ((i16 >> 2) ^ 3)) * 32 + (i16 & 3) * 8;
    if (first) Pat2<4>::first(pre.fa, pre.fb, prow, t0, lane, kcol, vcol);
    Pat2<4>::template run<5>(a, ext_h, prow, t0, lane, kcol, vcol, A, B, pre.fa, pre.fb);
    Pat2<2>::first(pre.fa, pre.fb, prow, t0, lane, kcol, vcol);
    Pat2<2>::template run<6>(a, ext_h, prow, t0, lane, kcol, vcol, A, B, pre.fa, pre.fb);
    p1_consec(lds, ext_h, prow, h, 256 * blk, w, lane, A, B);
    if (has_next) {
        const int ln = fresh_tid() & 63; const int vch2 = ln & 7;
        const unsigned kcol2 = (unsigned)(COL_KA + 64 * (h + 2) + 8 * vch2) * 2u, vcol2 = (unsigned)(COL_VA + 64 * (h + 2) + 8 * vch2) * 2u;
        Pat2<4>::first(pre.fa, pre.fb, prow, t0, ln, kcol2, vcol2);
        const bf16_t* qn = prow + (size_t)(t0 + 16 * (ln & 15)) * NPROJ + COL_QA + 64 * (h + 2) + 8 * (ln >> 4);
        pre.q0 = *(const bf16x8*)qn; pre.q1 = *(const bf16x8*)(qn + 32); pre.q2 = *(const bf16x8*)(qn + 8 * NPROJ); pre.q3 = *(const bf16x8*)(qn + 8 * NPROJ + 32);
    }
    store_item(A, O, (size_t)b * SEQ + 256 * blk + 32 * w + i16, h, fq);
    store_item(B, O, (size_t)b * SEQ + 256 * blk + 32 * w + 16 + i16, h, fq);
}
#undef MF16
#undef VFR
}

__device__ __forceinline__ int rowmap(int n, int mode) {
    if (mode == 1) { if (n >= COL_KR) { const int c = n - COL_KR; return COL_KR + (c < 16 ? 2 * c : 2 * (c - 16) + 1); } return n; }
    if (mode == 2) { const int h = n / 96, w = n % 96; if (w >= 64) { const int c = w - 64; return 96 * h + 64 + (c < 16 ? 2 * c : 2 * (c - 16) + 1); } return n; }
    return n;
}
__device__ __forceinline__ void p0_transpose_item(const float* __restrict__ W, const float* __restrict__ g, int K, int N, bf16_t* __restrict__ WT, int mode, LAS float* scr, int item, int lane) {
    const int nblk = N / 32, kb = item / nblk, nb = item % nblk, k0 = 64 * kb, n0 = 32 * nb;
#pragma unroll
    for (int i = 0; i < 32; ++i) { const int kk = 2 * i + (lane >> 5); const float gv = g ? g[k0 + kk] : 1.f; scr[kk * 33 + (lane & 31)] = W[(size_t)(k0 + kk) * N + n0 + (lane & 31)] * gv; }
    asm volatile("s_waitcnt lgkmcnt(0)" ::: "memory");
    const int c = lane & 7;
#pragma unroll
    for (int j = 0; j < 4; ++j) { const int n = (lane >> 3) + 8 * j; const LAS float* s = scr + (8 * c) * 33 + n;
        u32x4 o; o.x = cvtpk(s[0 * 33], s[1 * 33]); o.y = cvtpk(s[2 * 33], s[3 * 33]); o.z = cvtpk(s[4 * 33], s[5 * 33]); o.w = cvtpk(s[6 * 33], s[7 * 33]);
        *(u32x4*)(WT + (size_t)rowmap(n0 + n, mode) * K + k0 + 8 * c) = o; }
    asm volatile("s_waitcnt lgkmcnt(0)" ::: "memory");
}

__device__ __forceinline__ void grid_barrier(unsigned* bar, unsigned G, unsigned& epoch) {
    asm volatile("s_waitcnt vmcnt(0)" ::: "memory");
    __syncthreads();
    if (threadIdx.x == 0) {
        __builtin_amdgcn_fence(__ATOMIC_RELEASE, "agent");
        asm volatile("s_waitcnt vmcnt(0)" ::: "memory");
        const unsigned target = (epoch + 1u) * G;
        __hip_atomic_fetch_add(bar, 1u, __ATOMIC_RELAXED, __HIP_MEMORY_SCOPE_AGENT);
        unsigned spins = 0;
        while (__hip_atomic_load(bar, __ATOMIC_RELAXED, __HIP_MEMORY_SCOPE_AGENT) < target) { __builtin_amdgcn_s_sleep(2); if (++spins > (1u << 24)) break; }
        __builtin_amdgcn_fence(__ATOMIC_ACQUIRE, "agent");
        asm volatile("s_waitcnt vmcnt(0)" ::: "memory");
    }
    ++epoch;
    __syncthreads();
}

#define XB_TMO      128
#define XB_XCNT(j)  (256  + 64 * (j))
#define XB_XSUB(j)  (1280 + 64 * (j))
#define XB_XGEN(j)  (2304 + 64 * (j))
#define XB_TOP      3328
#define XB_TOPGEN   3392
#define XCD_BAR_WORDS 3456
#define XB_SPIN_CAP (1u << 18)
__device__ __forceinline__ unsigned xb_ld(unsigned* p)              { return __hip_atomic_load(p, __ATOMIC_RELAXED, __HIP_MEMORY_SCOPE_AGENT); }
__device__ __forceinline__ unsigned xb_add(unsigned* p, unsigned v) { return __hip_atomic_fetch_add(p, v, __ATOMIC_RELAXED, __HIP_MEMORY_SCOPE_AGENT); }
__device__ __forceinline__ unsigned xb_xcc_id() { return (unsigned)__builtin_amdgcn_s_getreg((3 << 11) | 20) & 0xFu; }
#define XB_SPIN(cond, bar) do { unsigned _sp = 0; while (cond) { __builtin_amdgcn_s_sleep(1); \
    if ((++_sp & 255u) == 0u) { if (xb_ld(&(bar)[XB_TMO])) break; if (_sp > XB_SPIN_CAP) { atomicAdd(&(bar)[XB_TMO], 1u); break; } } } } while (0)
struct XcdBarrier { unsigned* bar; unsigned x; volatile LAS unsigned* st; };
__device__ __forceinline__ XcdBarrier xcd_barrier_post(unsigned* bar, volatile LAS unsigned* st) {
    XcdBarrier b; b.bar = bar; b.x = xb_xcc_id(); b.st = st;
    if (threadIdx.x == 0) (void)xb_add(&bar[XB_XCNT(b.x)], 1u);
    return b;
}
__device__ __forceinline__ void xcd_barrier_complete(unsigned* bar, unsigned x, unsigned& nloc, unsigned& nx) {
    const unsigned G = gridDim.x;
    unsigned sum, cnt, mine, sp = 0u;
    for (;;) {
        sum = 0u; cnt = 0u; mine = 0u;
#pragma unroll
        for (unsigned j = 0; j < 16; ++j) { const unsigned c = xb_ld(&bar[XB_XCNT(j)]); sum += c; cnt += (c > 0u) ? 1u : 0u; mine = (j == x) ? c : mine; }
        if (sum == G) break;
        __builtin_amdgcn_s_sleep(1);
        if ((++sp & 255u) == 0u) { if (xb_ld(&bar[XB_TMO])) break; if (sp > XB_SPIN_CAP) { atomicAdd(&bar[XB_TMO], 1u); break; } }
    }
    nloc = mine > 0u ? mine : 1u; nx = cnt > 0u ? cnt : 1u;
}
__device__ __forceinline__ void xcd_barrier(const XcdBarrier& b) {
    asm volatile("s_waitcnt vmcnt(0)" ::: "memory");
    __syncthreads();
    if (threadIdx.x == 0) {
        unsigned* bar = b.bar;
        __builtin_amdgcn_s_waitcnt(0);
        unsigned nloc = b.st[0], nx = b.st[1];
        if (nloc == 0u) { xcd_barrier_complete(bar, b.x, nloc, nx); b.st[0] = nloc; b.st[1] = nx; }
        const unsigned old = xb_add(&bar[XB_XSUB(b.x)], 1u);
        const unsigned gen = old / nloc;
        if (old + 1u == (gen + 1u) * nloc) {
            __builtin_amdgcn_fence(__ATOMIC_RELEASE, "agent");
            asm volatile("s_waitcnt vmcnt(0)" ::: "memory");
            const unsigned og = xb_add(&bar[XB_TOP], 1u);
            const unsigned tg = og / nx;
            if (og + 1u == (tg + 1u) * nx) xb_add(&bar[XB_TOPGEN], 1u);
            else XB_SPIN(xb_ld(&bar[XB_TOPGEN]) == tg, bar);
            __builtin_amdgcn_fence(__ATOMIC_ACQUIRE, "agent");
            xb_add(&bar[XB_XGEN(b.x)], 1u);
            asm volatile("s_waitcnt vmcnt(0)" ::: "memory");
        } else {
            XB_SPIN(xb_ld(&bar[XB_XGEN(b.x)]) == gen, bar);
            __builtin_amdgcn_fence(__ATOMIC_ACQUIRE, "agent");
            asm volatile("s_waitcnt vmcnt(0)" ::: "memory");
        }
    }
    __syncthreads();
}

__device__ __forceinline__ void transpose_item64(const float* __restrict__ W, const float* __restrict__ g, int K, int N, bf16_t* __restrict__ WT, int MODE, LAS unsigned* scr, int item, int lane) {
    const int nblk = (N + 63) / 64, kb = item / nblk, nb = item % nblk, k0 = 64 * kb, n0 = 64 * nb;
    const int nq = lane & 15, kq = lane >> 4;
    f32x4 a[8], b[8];
#pragma unroll
    for (int j = 0; j < 8; ++j) { const int nn = (n0 + 4 * nq < N) ? n0 + 4 * nq : N - 4;
        const float* p = W + (size_t)(k0 + 2 * (4 * j + kq)) * N + nn; a[j] = __builtin_nontemporal_load((const f32x4*)p); b[j] = __builtin_nontemporal_load((const f32x4*)(p + N)); }
#pragma unroll
    for (int j = 0; j < 8; ++j) { const int kp = 4 * j + kq; float g0 = 1.f, g1 = 1.f; if (g) { g0 = g[k0 + 2 * kp]; g1 = g[k0 + 2 * kp + 1]; }
#pragma unroll
        for (int i = 0; i < 4; ++i) scr[(4 * nq + i) * 33 + kp] = cvtpk(a[j][i] * g0, b[j][i] * g1); }
    asm volatile("s_waitcnt lgkmcnt(0)" ::: "memory");
    const int c = lane & 7;
#pragma unroll
    for (int j = 0; j < 8; ++j) { const int n = (lane >> 3) + 8 * j; const LAS unsigned* sp = scr + n * 33 + 4 * c;
        u32x4 o; o.x = sp[0]; o.y = sp[1]; o.z = sp[2]; o.w = sp[3];
        if (n0 + n < N) *(u32x4*)(WT + (size_t)rowmap(n0 + n, MODE) * K + k0 + 8 * c) = o; }
    asm volatile("s_waitcnt lgkmcnt(0)" ::: "memory");
}

struct Args { const float* in[13]; float* out; unsigned char* ws; int ph_lo, ph_hi; int flags; int pad; };

__global__ void __launch_bounds__(NTHREADS, 2) mega(Args args) {
    extern __shared__ __attribute__((aligned(16))) unsigned char lds_raw[];
    LAS unsigned char* lds = (LAS unsigned char*)lds_raw;
    const int wid = __builtin_amdgcn_readfirstlane((int)threadIdx.x >> 6);
    const int G = gridDim.x, bx = blockIdx.x;
    const int vcu = (G % 8 == 0) ? (bx % 8) * (G / 8) + bx / 8 : bx;
    const int gw = vcu * NWAVES + wid, NGW = G * NWAVES;
    unsigned char* ws = args.ws;
    const float* x = args.in[0]; float* out = args.out;
    float* ssq_q = (float*)(ws + WS_SSQ_Q); float* ssq_kv = (float*)(ws + WS_SSQ_KV); float* ssq_h1 = (float*)(ws + WS_SSQ_H1); float* ssq_h2 = (float*)(ws + WS_SSQ_H2);
    float2* rope = (float2*)(ws + WS_ROPE); float* xrs = (float*)(ws + WS_XRS);
    bf16_t* Wt_in = (bf16_t*)(ws + WS_WIN); bf16_t* Wt_qb = (bf16_t*)(ws + WS_WQB); bf16_t* Wt_kvb = (bf16_t*)(ws + WS_WKVB);
    bf16_t* Wt_out = (bf16_t*)(ws + WS_WOUT); bf16_t* Wt_up = (bf16_t*)(ws + WS_WUP); bf16_t* Wt_down = (bf16_t*)(ws + WS_WDOWN);
    bf16_t* xn = (bf16_t*)(ws + WS_XN); bf16_t* o = (bf16_t*)(ws + WS_O); bf16_t* proj = (bf16_t*)(ws + WS_PROJ);
    bf16_t* qb = (bf16_t*)(ws + WS_QB); bf16_t* kvb = (bf16_t*)(ws + WS_KVB); bf16_t* kpe = (bf16_t*)(ws + WS_KPE);
    bf16_t* h1b = (bf16_t*)(ws + WS_H1B); bf16_t* act = (bf16_t*)(ws + WS_ACT);
    const int lo = args.ph_lo, hi = args.ph_hi;
#define IN(k) (lo <= (k) && (k) < hi)
    volatile LAS unsigned* bst = (volatile LAS unsigned*)(lds + LDS_BYTES - 64);
    XcdBarrier xbar; xbar.bar = (unsigned*)(ws + WS_CTL + 512 * 1024); xbar.x = 0; xbar.st = bst;
    if (hi - lo > 1) {
        { u32x4* z = (u32x4*)(ws + WS_CTL); for (int i = bx * NTHREADS + (int)threadIdx.x; i < (int)(CTL_BYTES / 16); i += G * NTHREADS) if (i < 32768 || i >= 33792) z[i] = (u32x4){0u, 0u, 0u, 0u}; }
        if (args.flags < 0) cg::this_grid().sync();
        if (threadIdx.x < 2) bst[threadIdx.x] = 0u;
        __syncthreads();
        xbar = xcd_barrier_post((unsigned*)(ws + WS_CTL + 512 * 1024), bst);
    }
#define SEAM(k) do { if (IN(k) && IN((k) + 1)) xcd_barrier(xbar); } while (0)

    if (IN(0)) {
        const int tid = fresh_tid(), lane = tid & 63;
        LAS float* scr = (LAS float*)(lds + wid * 16384);
        constexpr int I_IN = (DM / 64) * ((NPROJ_REAL + 63) / 64), I_QB = (256 / 64) * (NQB / 64), I_KVB = (128 / 64) * (NKVB / 64);
        constexpr int NITEMS = I_IN + I_QB + I_KVB;
#pragma unroll 1
        for (int it = gw; it < NITEMS; it += NGW) {
            int r = it; const float* W = args.in[2]; const float* gn = args.in[1]; int K = DM, N = NPROJ_REAL, mode = 1; bf16_t* WT = Wt_in;
            if (r >= I_IN) { r -= I_IN; W = args.in[4]; gn = args.in[3]; K = 256; N = NQB; mode = 2; WT = Wt_qb;
                if (r >= I_QB) { r -= I_QB; W = args.in[6]; gn = args.in[5]; K = 128; N = NKVB; mode = 0; WT = Wt_kvb; } }
            transpose_item64(W, gn, K, N, WT, mode, (LAS unsigned*)scr, r, lane);
        }
        { u32x4* z = (u32x4*)(Wt_in + (size_t)NPROJ_REAL * DM); const int nz = (NPROJ - NPROJ_REAL) * DM * 2 / 16;
          for (int i = bx * NTHREADS + tid; i < nz; i += G * NTHREADS) z[i] = (u32x4){0u, 0u, 0u, 0u}; }
        for (int idx = bx * NTHREADS + tid; idx < SEQ * 16; idx += G * NTHREADS) { const int t = idx >> 4, j = idx & 15;
            const float invf = powf(10000.0f, -(float)(2 * j) / 32.0f); const float ang = (float)t * invf; float s, c; sincosf(ang, &s, &c); rope[idx] = make_float2(c, s); }
        for (int m = gw; m < MTOK; m += 4 * NGW) {
            f32x4 v[4][4];
#pragma unroll
            for (int q = 0; q < 4; ++q) { const f32x4* xr = (const f32x4*)(x + (size_t)(m + q * NGW) * DM) + lane;
#pragma unroll
                for (int j = 0; j < 4; ++j) v[q][j] = __builtin_nontemporal_load(xr + 64 * j); }
#pragma unroll
            for (int q = 0; q < 4; ++q) { float s = 0.f;
#pragma unroll
                for (int j = 0; j < 4; ++j) s += pg8::sq4(v[q][j]);
                const float ms = wave_sum(s) * (1.f / DM) + EPS; const float rstd = rsqrtf(ms);
                if (lane == 0) xrs[m + q * NGW] = sqrtf(ms);
                u32x2* op = (u32x2*)(xn + (size_t)(m + q * NGW) * DM) + lane;
#pragma unroll
                for (int j = 0; j < 4; ++j) { u32x2 w; w.x = cvtpk(v[q][j][0] * rstd, v[q][j][1] * rstd); w.y = cvtpk(v[q][j][2] * rstd, v[q][j][3] * rstd); op[64 * j] = w; } }
        }
        __syncthreads();
    }
    SEAM(0);
    if (IN(1)) {
        pg8::Gemm g{xn, Wt_in, DM, DM, DM}; pg8::StaticOrder S; S.init(MTOK, NPROJ, G, bx);
        pg8::EpiProj E{proj, ssq_q, ssq_kv, kpe, rope};
        pg8::gemm_phase(lds, g, S, E);
    }
    SEAM(1);
    if (IN(2)) {
        { pg8::Gemm g{proj + COL_CQ, Wt_qb, NPROJ, 256, 256}; pg8::StaticOrder S; S.init(MTOK, NQB, G, bx); pg8::EpiQ E{qb, ssq_q, rope}; pg8::gemm_phase(lds, g, S, E); }
        { pg8::Gemm g{proj + COL_CKV, Wt_kvb, NPROJ, 128, 128}; pg8::StaticOrder S; S.init(MTOK, NKVB, G, (bx + G / 2) % G); pg8::EpiKV E{kvb, ssq_kv}; pg8::gemm_phase(lds, g, S, E); }
    }
    SEAM(2);
    if (IN(3)) {
        if (!(args.flags & 2)) {
#ifdef MLA_VARIANT
#define MLA_CALL do { if (args.flags & 16) mla::unit<MLA_VARIANT>(lds, bh >> 3, bh & 7, qblk, qb, kvb, kpe, o); else mla::unit<0>(lds, bh >> 3, bh & 7, qblk, qb, kvb, kpe, o); } while (0)
#else
#define MLA_CALL mla::unit<0>(lds, bh >> 3, bh & 7, qblk, qb, kvb, kpe, o)
#endif
            if (G == 256) { const int xcd = vcu >> 5, slot = vcu & 31;
                for (int i = 0; i < 4; ++i) { const int bh = xcd * 8 + i * 2 + (slot >> 4), qblk = slot & 15; MLA_CALL; } }
            else for (int u = vcu; u < BATCH * 8 * 16; u += G) { const int bh = u >> 4, qblk = u & 15; MLA_CALL; }
        }
        if (!(args.flags & 1)) {
            const int lane = fresh_tid() & 63;
            __syncthreads();
            if (G == 256) { const int b = vcu >> 5, slot = vcu & 31;
#ifdef DIL_VARIANT
                if (args.flags & 32) {
                    if (DIL_VARIANT == 11) { for (int i = 0; i < 4096; ++i) asm volatile("s_barrier" ::: "memory"); }
                    else if (DIL_VARIANT == 12) { float x = (float)lane; for (int i = 0; i < 4096; ++i) {
#pragma unroll
                        for (int j = 0; j < 64; ++j) x = __builtin_fmaf(x, 1.0000001f, 0.5f); asm volatile("" : "+v"(x)); }
                        if (x == 12345.f) o[0] = 1; }
                    else if (DIL_VARIANT == 13) { u32x4 v = (u32x4){(unsigned)lane, 1u, 2u, 3u}; LAS u32x4* p = (LAS u32x4*)(lds + wid * 4096 + lane * 16); LAS u32x4* q = (LAS u32x4*)(lds + ((wid + 1) & 7) * 4096 + lane * 16);
                        for (int i = 0; i < 4096; ++i) { *p = v; asm volatile("s_waitcnt lgkmcnt(0)\n\ts_barrier" ::: "memory"); v = *q; asm volatile("s_waitcnt lgkmcnt(0)\n\ts_barrier" ::: "memory"); }
                        if (v.x == 0x12345678u) o[0] = 1; }
                } else
#endif
                { LAS float* ext4 = (LAS float*)(lds + 131072); dil2::build_ext_all(ext4, args.in[11], slot & 1); __syncthreads();
                  dil2::Pre pre;
                  for (int i = 0; i < 4; ++i) dil2::round<0>(lds, ext4 + i * dil2::T2_H, b, 2 * i + (slot & 1), slot >> 1, wid, proj, o, lane, pre, i == 0, i < 3); } }
            else {
                LAS float* ext = (LAS float*)(lds + 65536);
                dil::build_ext(ext, args.in[11]);
                __syncthreads();
                LAS unsigned char* vst = lds + wid * 8192;
                for (int it = gw * 8; it < BATCH * 8 * 16 * 16; it += NGW * 8)
                    for (int k = 0; k < 8; ++k) { const int id = it + k; const int r = id & 15, blk = (id >> 4) & 15, h = (id >> 8) & 7, b = id >> 11; dil::item<false, 0>(vst, ext, lds + 102400, 0, b, h, blk, r, proj, o, lane); }
            }
            __syncthreads();
        }
        { const int lane = fresh_tid() & 63;
          unsigned* qctr = (unsigned*)(ws + WS_CTL + 700 * 1024);
          constexpr int L_OUT = (DM / 64) * (DM / 64), L_UP = (DM / 64) * (DFF / 64), L_DN = (DFF / 64) * (DM / 64);
          LAS unsigned* scr2 = (LAS unsigned*)(lds + wid * 16384);
          LAS unsigned* qs = (LAS unsigned*)(lds + 131072);
          for (;;) {
              __syncthreads();
              if (threadIdx.x == 0) qs[0] = __hip_atomic_fetch_add(qctr, 1u, __ATOMIC_RELAXED, __HIP_MEMORY_SCOPE_AGENT);
              __syncthreads();
              const int chunk = __builtin_amdgcn_readfirstlane((int)qs[0]);
              if (chunk * 16 >= L_OUT + L_UP + L_DN) break;
#pragma unroll 1
              for (int k = 0; k < 2; ++k) { int r = chunk * 16 + wid * 2 + k;
                  if (r < L_OUT) { transpose_item64(args.in[7], nullptr, DM, DM, Wt_out, 0, scr2, r, lane); continue; } r -= L_OUT;
                  if (r < L_UP) { transpose_item64(args.in[9], args.in[8], DM, DFF, Wt_up, 0, scr2, r, lane); continue; } r -= L_UP;
                  transpose_item64(args.in[10], nullptr, DFF, DM, Wt_down, 0, scr2, r, lane); }
          }
          __syncthreads(); }
    }
    SEAM(3);
    if (IN(4)) {
        pg8::Gemm g{o, Wt_out, DM, DM, DM}; pg8::StaticOrder S; S.init(MTOK, DM, G, bx);
        pg8::EpiOut E{xn, xrs, h1b, ssq_h1};
        pg8::gemm_phase(lds, g, S, E);
    }
    SEAM(4);
    if (IN(5)) {
        pg8::Gemm g{h1b, Wt_up, DM, DM, DM}; pg8::StaticOrder S; S.init(MTOK, DFF, G, bx);
        pg8::EpiUp E{act, ssq_h1};
        pg8::gemm_phase(lds, g, S, E);
    }
    SEAM(5);
    const bool fuse_final = (G == 256);
    if (IN(6)) {
        pg8::Gemm g{act, Wt_down, DFF, DFF, DFF}; pg8::StaticOrder S; S.init(MTOK, DM, G, bx);
        if (fuse_final) { pg8::EpiDownFused E{h1b, out, args.in[12], (float*)(ws + WS_XBUF), (unsigned*)(ws + WS_CTL + 576 * 1024), lds + pg8::STAGE_BYTES}; pg8::gemm_phase(lds, g, S, E); }
        else { pg8::EpiDown E{h1b, out, ssq_h2}; pg8::gemm_phase(lds, g, S, E); }
    }
    if (!fuse_final) {
    SEAM(6);
    if (IN(7)) {
        const int lane = fresh_tid() & 63;
        const f32x4* gr = (const f32x4*)args.in[12] + lane; f32x4 gg[4];
#pragma unroll
        for (int j = 0; j < 4; ++j) gg[j] = gr[64 * j];
        for (int m = gw; m < MTOK; m += NGW) {
            const float r = rsqrtf(ssq_h2[m] * (1.f / DM) + EPS);
            f32x4* xr = (f32x4*)(out + (size_t)m * DM) + lane;
#pragma unroll
            for (int j = 0; j < 4; ++j) xr[64 * j] = xr[64 * j] * gg[j] * r;
        }
    }
    }
#undef IN
#undef SEAM
}

extern "C" void kernel_launch(void* const* d_in, const int* in_sizes, int n_in, void* d_out, int out_size, void* d_ws, size_t ws_size, hipStream_t stream) {
    if (ws_size < WS_END || n_in < 13) { fprintf(stderr, "kernel_launch: workspace too small (%zu) or inputs missing (%d)\n", ws_size, n_in); return; }
    static int grid = 0;
    if (grid == 0) {
        int dev = 0, cus = 0, per_cu = 0;
        (void)hipGetDevice(&dev); (void)hipDeviceGetAttribute(&cus, hipDeviceAttributeMultiprocessorCount, dev);
        if (hipFuncSetAttribute((const void*)mega, hipFuncAttributeMaxDynamicSharedMemorySize, LDS_BYTES) != hipSuccess) { fprintf(stderr, "kernel_launch: hipFuncSetAttribute failed\n"); grid = -1; return; }
        if (hipOccupancyMaxActiveBlocksPerMultiprocessor(&per_cu, (const void*)mega, NTHREADS, LDS_BYTES) != hipSuccess || per_cu < 1) { fprintf(stderr, "kernel_launch: occupancy query failed (%d)\n", per_cu); per_cu = 1; }
        (void)hipGetLastError();
        grid = cus;
        if (grid <= 0) grid = 256;
    }
    if (grid < 0) return;
    unsigned char* ws = (unsigned char*)d_ws; float* out = (float*)d_out;
    (void)hipMemsetAsync(ws + WS_CTL + 512 * 1024, 0, 16 * 1024, stream);
    Args a{};
    for (int i = 0; i < 13; ++i) a.in[i] = (const float*)d_in[i];
    a.out = out; a.ws = ws;
    a.ph_lo = 0; a.ph_hi = 8; a.flags = 0;
    void* kargs[] = {&a};
    hipError_t e = hipLaunchCooperativeKernel((const void*)mega, dim3(grid), dim3(NTHREADS), kargs, LDS_BYTES, stream);
    if (e != hipSuccess) fprintf(stderr, "kernel_launch: cooperative launch failed: %s (grid %d)\n", hipGetErrorString(e), grid);
}
```

```cpp
#include <hip/hip_runtime.h>
#include <cstdint>
#include <cstdio>

typedef unsigned short bf16_t;

constexpr int BATCH = 8, SEQ = 4096, DM = 1024, MTOK = BATCH * SEQ;
constexpr int NPROJ = 2048;
constexpr int NPROJ_REAL = 1952;
constexpr int COL_QA = 0, COL_KA = 512, COL_VA = 1024, COL_CQ = 1536, COL_CKV = 1792, COL_KR = 1920;
constexpr int NQB = 768, NKVB = 1024, DFF = 4096;
constexpr float EPS = 1e-6f;
constexpr float LOG2E = 1.4426950408889634f;
constexpr float QSCALE_A = 0.125f * LOG2E;
constexpr float QSCALE_B = 0.10206207261596575f * LOG2E;

constexpr size_t MiB = 1u << 20;
constexpr size_t WS_CTL = 0, CTL_BYTES = 1 * MiB;
constexpr size_t WS_SSQ_Q = 0, WS_SSQ_KV = 128 * 1024, WS_SSQ_H1 = 256 * 1024, WS_SSQ_H2 = 384 * 1024;
constexpr size_t WS_ROPE = 1 * MiB;
constexpr size_t WS_XBUF = 1 * MiB + 512 * 1024;
constexpr size_t WS_WIN = 2 * MiB, WS_WQB = 6 * MiB, WS_WKVB = 7 * MiB, WS_WOUT = 8 * MiB, WS_WUP = 10 * MiB, WS_WDOWN = 18 * MiB;
constexpr size_t WS_XN = 32 * MiB, WS_O = 404 * MiB, WS_XRS = 468 * MiB;
constexpr size_t WS_PROJ = 96 * MiB, WS_QB = 224 * MiB, WS_KVB = 272 * MiB, WS_KPE = 336 * MiB, WS_H1B = 340 * MiB;
constexpr size_t WS_ACT = 32 * MiB;
constexpr size_t WS_END = 469 * MiB;

__device__ __forceinline__ unsigned f2bf(float f) { unsigned u = __builtin_bit_cast(unsigned, f); return (u + 0x7fffu + ((u >> 16) & 1u)) >> 16; }
__device__ __forceinline__ float bf2f(bf16_t h) { return __builtin_bit_cast(float, (unsigned)h << 16); }
__device__ __forceinline__ float wave_sum(float v) {
#pragma unroll
    for (int o = 1; o < 64; o <<= 1) v += __shfl_xor(v, o);
    return v;
}
__device__ __forceinline__ float wave_max(float v) {
#pragma unroll
    for (int o = 1; o < 64; o <<= 1) v = fmaxf(v, __shfl_xor(v, o));
    return v;
}
__device__ __forceinline__ int t5_bucket(int rel) {
    const int n = rel < 0 ? -rel : rel;
    int b;
    if (n < 8) b = n;
    else b = 8 + (n >= 15) + (n >= 27) + (n >= 50) + (n >= 91) + (n >= 166) + (n >= 305) + (n >= 559);
    return b + (rel > 0 ? 16 : 0);
}


#include <hip/hip_cooperative_groups.h>
namespace cg = cooperative_groups;
#define LAS __attribute__((address_space(3)))
typedef short bf16x8 __attribute__((ext_vector_type(8)));
typedef short s16x4 __attribute__((ext_vector_type(4)));
typedef float f32x4 __attribute__((ext_vector_type(4)));
typedef float f32x16 __attribute__((ext_vector_type(16)));
typedef unsigned u32x4 __attribute__((ext_vector_type(4)));
typedef unsigned u32x2 __attribute__((ext_vector_type(2)));
typedef float f32x2_t __attribute__((ext_vector_type(2)));
typedef __bf16 bf16x2_t __attribute__((ext_vector_type(2)));
__device__ __forceinline__ unsigned cvtpk(float lo, float hi) { f32x2_t v = {lo, hi}; bf16x2_t b = __builtin_convertvector(v, bf16x2_t); return __builtin_bit_cast(unsigned, b); }
__device__ __forceinline__ s16x4 tr16(const LAS unsigned char* p) { typedef short v4i16_t __attribute__((ext_vector_type(4))); return __builtin_bit_cast(s16x4, __builtin_amdgcn_ds_read_tr16_b64_v4i16((LAS v4i16_t*)p)); }

constexpr int NWAVES = 8, NTHREADS = 512;
__device__ __forceinline__ int fresh_tid() { int t = threadIdx.x; asm volatile("" : "+v"(t)); return t; }
constexpr int LDS_BYTES = 147456;

namespace pg8 {
constexpr int BM = 256, BK = 64, HALF = 128, HTB = HALF * BK * 2, STAGE_BYTES = 8 * HTB, NXCD = 8, WGM = 8;
__host__ __device__ __forceinline__ int lds_byte(int r, int c) { const int st = (r >> 4) * 2 + (c >> 5), rr = r & 15, cc = c & 31, ob = rr * 64 + cc * 2; return st * 1024 + (ob ^ (((ob >> 9) & 1) << 5)); }
__host__ __device__ __forceinline__ void stage_rc(int b, int& R, int& C) { const int st = b / 1024, sb = b % 1024, swz = sb ^ (((sb >> 9) & 1) << 5); R = (st >> 1) * 16 + swz / 64; C = (st & 1) * 32 + (swz % 64) / 2; }
__host__ __device__ __forceinline__ int perm32(int rho) { const int n = rho >> 4, i = rho & 15; return 8 * (i >> 2) + 4 * n + (i & 3); }
struct Unit { int pm, pn; };
struct Gemm { const bf16_t* A; const bf16_t* Bt; int lda, ldb, K; };
struct StaticOrder {
    int nM, nN, nwg, G, c;
    __device__ void init(int M, int N, int G_, int c_) { nM = M / BM; nN = N / BM; nwg = nM * nN; G = G_; c = c_; }
    __device__ bool next(int i, Unit& u) const {
        const long L = (long)i * G + c; if (L >= nwg) return false;
        int wgid = (int)L; { const int q = nwg / NXCD, r = nwg % NXCD, xcd = wgid % NXCD, off = wgid / NXCD; wgid = (xcd < r ? xcd * (q + 1) : r * (q + 1) + (xcd - r) * q) + off; }
        const int nig = WGM * nN, gid = wgid / nig, fm = gid * WGM, gsz = (nM - fm) < WGM ? (nM - fm) : WGM;
        u.pm = fm + ((wgid % nig) % gsz); u.pn = (wgid % nig) / gsz; return true;
    }
};
struct PanelOrder { int pm, n; __device__ bool next(int i, Unit& u) const { if (i >= n) return false; u.pm = pm; u.pn = i; return true; } };
template <class Epi, class Order>
__device__ __forceinline__ void gemm_phase(LAS unsigned char* lds, const Gemm g, const Order& S, const Epi& E) {
    const int tid = fresh_tid(), wid = __builtin_amdgcn_readfirstlane(tid >> 6), lane = tid & 63, wr = wid >> 2, wc = wid & 3, fr = lane & 15, fq = lane >> 4;
    const int K = g.K, nt = K / BK;
    unsigned voffA[2], voffB[2];
#pragma unroll
    for (int i = 0; i < 2; ++i) { int R, C; stage_rc(tid * 16 + i * 8192, R, C); const int Rb = (R & ~31) + perm32(R & 31);
        voffA[i] = (unsigned)(R * g.lda + C) * 2u; voffB[i] = (unsigned)(Rb * g.ldb + C) * 2u; }
    const size_t kstep = (size_t)(BK * 2);
    const size_t hstepA = (size_t)HALF * g.lda * 2, hstepB = (size_t)HALF * g.ldb * 2;
    const size_t tstepA = 2 * hstepA, tstepB = 2 * hstepB;
    const unsigned ldsw = (unsigned)wid * 1024u;
    const int aoff = lds_byte(wr * 64 + fr, fq * 8), boff = lds_byte(wc * 32 + fr, fq * 8);
#define PG8_SA(b, h) (((b) * 2 + (h)) * HTB)
#define PG8_SB(b, h) ((4 + (b) * 2 + (h)) * HTB)
#define PG8_STAGE(bufoff, gbase, voff) do { _Pragma("unroll") for (int _i = 0; _i < 2; ++_i) \
        __builtin_amdgcn_global_load_lds((const unsigned*)((const char*)(gbase) + (voff)[_i]), (LAS unsigned*)(lds + (bufoff) + ldsw + _i * 8192), 16, 0, 0); } while (0)
#define PG8_LDA(dst, b, h) do { _Pragma("unroll") for (int m = 0; m < 4; ++m) _Pragma("unroll") for (int k = 0; k < 2; ++k) dst[m][k] = *(const LAS bf16x8*)(lds + PG8_SA(b, h) + aoff + m * 2048 + k * 1024); } while (0)
#define PG8_LDB(dst, b, h) do { _Pragma("unroll") for (int n = 0; n < 2; ++n) _Pragma("unroll") for (int k = 0; k < 2; ++k) dst[n][k] = *(const LAS bf16x8*)(lds + PG8_SB(b, h) + boff + n * 2048 + k * 1024); } while (0)
#define PG8_MMA(ai, bj, At, Bt) do { __builtin_amdgcn_s_setprio(1); _Pragma("unroll") for (int m = 0; m < 4; ++m) _Pragma("unroll") for (int n = 0; n < 2; ++n) _Pragma("unroll") for (int k = 0; k < 2; ++k) \
        acc[ai][bj][m][n] = __builtin_amdgcn_mfma_f32_16x16x32_bf16(Bt[n][k], At[m][k], acc[ai][bj][m][n], 0, 0, 0); __builtin_amdgcn_s_setprio(0); } while (0)
#define PG8_WAIT_V(n) asm volatile("s_waitcnt vmcnt(" #n ")" ::: "memory")
#define PG8_WAIT_L(n) asm volatile("s_waitcnt lgkmcnt(" #n ")" ::: "memory")
#define PG8_BAR __builtin_amdgcn_s_barrier()
#define PG8_SCHED __builtin_amdgcn_sched_barrier(0)
    Unit cur, nxt; int ui = 0;
    if (!S.next(0, cur)) return;
    f32x4 acc[2][2][4][2];
#pragma unroll
    for (int a = 0; a < 2; ++a)
#pragma unroll
        for (int b = 0; b < 2; ++b)
#pragma unroll
            for (int m = 0; m < 4; ++m)
#pragma unroll
                for (int n = 0; n < 2; ++n) acc[a][b][m][n] = (f32x4){0.f, 0.f, 0.f, 0.f};
    bf16x8 At[4][2], B0[2][2], B1[2][2];
    const char* cA = (const char*)g.A + (size_t)cur.pm * tstepA; const char* cB = (const char*)g.Bt + (size_t)cur.pn * tstepB;
    PG8_STAGE(PG8_SB(0, 0), cB, voffB); PG8_STAGE(PG8_SB(0, 1), cB + hstepB, voffB); PG8_STAGE(PG8_SA(0, 0), cA, voffA); PG8_STAGE(PG8_SA(0, 1), cA + hstepA, voffA);
    if (wr == 1) PG8_BAR;
    PG8_WAIT_V(2); PG8_BAR;
    PG8_STAGE(PG8_SB(1, 0), cB + kstep, voffB); PG8_STAGE(PG8_SA(1, 0), cA + kstep, voffA); PG8_STAGE(PG8_SB(1, 1), cB + hstepB + kstep, voffB);
    PG8_WAIT_V(6); PG8_BAR;
    for (;;) {
        const bool has_next = S.next(ui + 1, nxt);
        const char* nA = has_next ? (const char*)g.A + (size_t)nxt.pm * tstepA : cA; const char* nB = has_next ? (const char*)g.Bt + (size_t)nxt.pn * tstepB : cB;
        for (int t = 0; t < nt; t += 2) {
            const bool last = (t == nt - 2);
            const char* a1 = cA + (size_t)(t + 1) * kstep;
            const char* a2 = last ? nA : cA + (size_t)(t + 2) * kstep; const char* b2 = last ? nB : cB + (size_t)(t + 2) * kstep;
            const char* a3 = a2 + kstep; const char* b3 = b2 + kstep;
            PG8_LDB(B0, 0, 0); PG8_LDB(B1, 0, 1); PG8_SCHED; PG8_LDA(At, 0, 0); PG8_STAGE(PG8_SA(1, 1), a1 + hstepA, voffA);
            PG8_WAIT_V(8); PG8_WAIT_L(0); PG8_BAR; PG8_MMA(0, 0, At, B0); PG8_MMA(0, 1, At, B1); PG8_BAR; PG8_SCHED;
            PG8_LDA(At, 0, 1); PG8_STAGE(PG8_SB(0, 0), b2, voffB); PG8_STAGE(PG8_SB(0, 1), b2 + hstepB, voffB); PG8_STAGE(PG8_SA(0, 0), a2, voffA);
            PG8_WAIT_V(8); PG8_WAIT_L(0); PG8_BAR; PG8_MMA(1, 0, At, B0); PG8_MMA(1, 1, At, B1); PG8_BAR; PG8_SCHED;
            PG8_LDB(B0, 1, 0); PG8_LDB(B1, 1, 1); PG8_SCHED; PG8_LDA(At, 1, 0); PG8_STAGE(PG8_SA(0, 1), a2 + hstepA, voffA);
            PG8_WAIT_V(8); PG8_WAIT_L(0); PG8_BAR; PG8_MMA(0, 0, At, B0); PG8_MMA(0, 1, At, B1); PG8_BAR; PG8_SCHED;
            PG8_LDA(At, 1, 1); PG8_STAGE(PG8_SB(1, 0), b3, voffB); PG8_STAGE(PG8_SB(1, 1), b3 + hstepB, voffB); PG8_STAGE(PG8_SA(1, 0), a3, voffA);
            PG8_WAIT_V(8); PG8_WAIT_L(0); PG8_BAR; PG8_MMA(1, 0, At, B0); PG8_MMA(1, 1, At, B1); PG8_BAR; PG8_SCHED;
        }
        if (wr == 0) PG8_BAR;
        { const int l2_ = fresh_tid() & 63; E(acc, cur, wr, wc, l2_ & 15, l2_ >> 4); }
        if (!has_next) break;
#pragma unroll
        for (int a = 0; a < 2; ++a)
#pragma unroll
            for (int b = 0; b < 2; ++b)
#pragma unroll
                for (int m = 0; m < 4; ++m)
#pragma unroll
                    for (int n = 0; n < 2; ++n) acc[a][b][m][n] = (f32x4){0.f, 0.f, 0.f, 0.f};
        cur = nxt; cA = nA; cB = nB; ++ui;
        if (wr == 1) PG8_BAR;
    }
    PG8_WAIT_V(0);
    PG8_BAR;
#undef PG8_SA
#undef PG8_SB
#undef PG8_STAGE
#undef PG8_LDA
#undef PG8_LDB
#undef PG8_MMA
#undef PG8_WAIT_V
#undef PG8_WAIT_L
#undef PG8_BAR
#undef PG8_SCHED
}
typedef const f32x4 (&AccRef)[2][2][4][2];
__device__ __forceinline__ float sq4(const f32x4 v) { return (v[0] * v[0] + v[1] * v[1]) + (v[2] * v[2] + v[3] * v[3]); }
__device__ __forceinline__ u32x4 pack8(const f32x4 a, const f32x4 b) { u32x4 w; w.x = cvtpk(a[0], a[1]); w.y = cvtpk(a[2], a[3]); w.z = cvtpk(b[0], b[1]); w.w = cvtpk(b[2], b[3]); return w; }
__device__ __forceinline__ float fq_sum(float s) { s += __shfl_xor(s, 16); s += __shfl_xor(s, 32); return s; }

struct EpiProj { bf16_t* proj; float* ssq_q; float* ssq_kv; bf16_t* kpe; const float2* rope;
    __device__ __forceinline__ void operator()(AccRef acc, const Unit& u, int wr, int wc, int fr, int fq) const {
        const int row0 = u.pm * BM + wr * 64 + fr, col0 = u.pn * BM + wc * 32 + 8 * fq;
        const float sc = u.pn < 2 ? QSCALE_A : 1.f;
        const bool dorope = (u.pn == 7) && (wc == 0);
        float2 cs[2][4][4];
        if (dorope) {
#pragma unroll
            for (int ai = 0; ai < 2; ++ai)
#pragma unroll
                for (int m = 0; m < 4; ++m) { const int t = (row0 + ai * HALF + m * 16) & (SEQ - 1); const float2* cp = rope + t * 16 + 4 * fq;
#pragma unroll
                    for (int q = 0; q < 4; ++q) cs[ai][m][q] = cp[q]; }
        }
#pragma unroll
        for (int ai = 0; ai < 2; ++ai)
#pragma unroll
            for (int m = 0; m < 4; ++m) { const int row = row0 + ai * HALF + m * 16; bf16_t* rp = proj + (size_t)row * NPROJ + col0;
#pragma unroll
                for (int bj = 0; bj < 2; ++bj) *(u32x4*)(rp + bj * HALF) = pack8(acc[ai][bj][m][0] * sc, acc[ai][bj][m][1] * sc);
                if (u.pn == 6) { float s = (sq4(acc[ai][0][m][0]) + sq4(acc[ai][0][m][1])) + (sq4(acc[ai][1][m][0]) + sq4(acc[ai][1][m][1])); s = fq_sum(s); if (fq == 0) atomicAdd(ssq_q + row, s); }
                if (u.pn == 7) { float s = sq4(acc[ai][0][m][0]) + sq4(acc[ai][0][m][1]); s = fq_sum(s); if (fq == 0) atomicAdd(ssq_kv + row, s);
                    if (wc == 0) { f32x4 a = acc[ai][1][m][0], b = acc[ai][1][m][1];
                        const float2 c0 = cs[ai][m][0], c1 = cs[ai][m][1], c2 = cs[ai][m][2], c3 = cs[ai][m][3];
                        f32x4 ra, rb; ra[0] = a[0] * c0.x - a[1] * c0.y; ra[1] = a[1] * c0.x + a[0] * c0.y; ra[2] = a[2] * c1.x - a[3] * c1.y; ra[3] = a[3] * c1.x + a[2] * c1.y;
                        rb[0] = b[0] * c2.x - b[1] * c2.y; rb[1] = b[1] * c2.x + b[0] * c2.y; rb[2] = b[2] * c3.x - b[3] * c3.y; rb[3] = b[3] * c3.x + b[2] * c3.y;
                        *(u32x4*)(kpe + (size_t)row * 32 + 8 * fq) = pack8(ra, rb); } }
            }
    } };
struct EpiQ { bf16_t* qb; const float* ssq_q; const float2* rope;
    __device__ __forceinline__ void operator()(AccRef acc, const Unit& u, int wr, int wc, int fr, int fq) const {
        const int row0 = u.pm * BM + wr * 64 + fr, col0 = u.pn * BM + wc * 32 + 8 * fq;
        const int w0 = col0 % 96, w1 = (col0 + HALF) % 96; const bool pe0 = w0 >= 64, pe1 = w1 >= 64; const int j0 = pe0 ? (w0 - 64) >> 1 : (pe1 ? (w1 - 64) >> 1 : 0);
        float rr[2][4];
#pragma unroll
        for (int ai = 0; ai < 2; ++ai)
#pragma unroll
            for (int m = 0; m < 4; ++m) rr[ai][m] = ssq_q[row0 + ai * HALF + m * 16];
#pragma unroll
        for (int ai = 0; ai < 2; ++ai) {
            f32x4 cs[4][2];
#pragma unroll
            for (int m = 0; m < 4; ++m) { cs[m][0] = (f32x4){1.f, 0.f, 1.f, 0.f}; cs[m][1] = cs[m][0];
                if (pe0 || pe1) { const f32x4* cp = (const f32x4*)(rope + ((row0 + ai * HALF + m * 16) & (SEQ - 1)) * 16 + j0); cs[m][0] = cp[0]; cs[m][1] = cp[1]; } }
#pragma unroll
            for (int m = 0; m < 4; ++m) asm volatile("" : "+v"(cs[m][0]), "+v"(cs[m][1]));
            __builtin_amdgcn_sched_barrier(0);
#pragma unroll
            for (int m = 0; m < 4; ++m) { const int row = row0 + ai * HALF + m * 16; const float r = rsqrtf(rr[ai][m] * (1.f / 256.f) + EPS);
#pragma unroll
                for (int bj = 0; bj < 2; ++bj) { f32x4 a = acc[ai][bj][m][0] * r, b = acc[ai][bj][m][1] * r;
                    if (bj == 0 ? pe0 : pe1) { const f32x4 ca = cs[m][0], cb = cs[m][1]; f32x4 ra, rb;
                        ra[0] = a[0] * ca[0] - a[1] * ca[1]; ra[1] = a[1] * ca[0] + a[0] * ca[1]; ra[2] = a[2] * ca[2] - a[3] * ca[3]; ra[3] = a[3] * ca[2] + a[2] * ca[3];
                        rb[0] = b[0] * cb[0] - b[1] * cb[1]; rb[1] = b[1] * cb[0] + b[0] * cb[1]; rb[2] = b[2] * cb[2] - b[3] * cb[3]; rb[3] = b[3] * cb[2] + b[2] * cb[3]; a = ra; b = rb; }
                    *(u32x4*)(qb + (size_t)row * NQB + col0 + bj * HALF) = pack8(a * QSCALE_B, b * QSCALE_B); } }
        }
    } };
struct EpiKV { bf16_t* kvb; const float* ssq_kv;
    __device__ __forceinline__ void operator()(AccRef acc, const Unit& u, int wr, int wc, int fr, int fq) const {
        const int row0 = u.pm * BM + wr * 64 + fr, col0 = u.pn * BM + wc * 32 + 8 * fq;
        float rr[2][4];
#pragma unroll
        for (int ai = 0; ai < 2; ++ai)
#pragma unroll
            for (int m = 0; m < 4; ++m) rr[ai][m] = ssq_kv[row0 + ai * HALF + m * 16];
#pragma unroll
        for (int ai = 0; ai < 2; ++ai)
#pragma unroll
            for (int m = 0; m < 4; ++m) { const int row = row0 + ai * HALF + m * 16; const float r = rsqrtf(rr[ai][m] * (1.f / 128.f) + EPS);
#pragma unroll
                for (int bj = 0; bj < 2; ++bj) *(u32x4*)(kvb + (size_t)row * NKVB + col0 + bj * HALF) = pack8(acc[ai][bj][m][0] * r, acc[ai][bj][m][1] * r); }
    } };
__device__ __forceinline__ f32x4 bf4lo(const u32x4 w) { f32x4 r; r[0] = __builtin_bit_cast(float, w.x << 16); r[1] = __builtin_bit_cast(float, w.x & 0xffff0000u); r[2] = __builtin_bit_cast(float, w.y << 16); r[3] = __builtin_bit_cast(float, w.y & 0xffff0000u); return r; }
__device__ __forceinline__ f32x4 bf4hi(const u32x4 w) { f32x4 r; r[0] = __builtin_bit_cast(float, w.z << 16); r[1] = __builtin_bit_cast(float, w.z & 0xffff0000u); r[2] = __builtin_bit_cast(float, w.w << 16); r[3] = __builtin_bit_cast(float, w.w & 0xffff0000u); return r; }
struct EpiOut { const bf16_t* xn; const float* xrs; bf16_t* h1b; float* ssq;
    __device__ __forceinline__ void operator()(AccRef acc, const Unit& u, int wr, int wc, int fr, int fq) const {
        const int row0 = u.pm * BM + wr * 64 + fr, col0 = u.pn * BM + wc * 32 + 8 * fq;
        u32x4 xw[2][4][2]; float rs[2][4];
#pragma unroll
        for (int ai = 0; ai < 2; ++ai)
#pragma unroll
            for (int m = 0; m < 4; ++m) { const int row = row0 + ai * HALF + m * 16; rs[ai][m] = xrs[row];
#pragma unroll
                for (int bj = 0; bj < 2; ++bj) xw[ai][m][bj] = *(const u32x4*)(xn + (size_t)row * DM + col0 + bj * HALF); }
#pragma unroll
        for (int ai = 0; ai < 2; ++ai)
#pragma unroll
            for (int m = 0; m < 4; ++m) { const int row = row0 + ai * HALF + m * 16; const size_t off = (size_t)row * DM + col0; const float r = rs[ai][m]; float s = 0.f;
#pragma unroll
                for (int bj = 0; bj < 2; ++bj) { const f32x4 a = bf4lo(xw[ai][m][bj]) * r + acc[ai][bj][m][0], b = bf4hi(xw[ai][m][bj]) * r + acc[ai][bj][m][1];
                    *(u32x4*)(h1b + off + bj * HALF) = pack8(a, b); s += sq4(a) + sq4(b); }
                s = fq_sum(s); if (fq == 0) atomicAdd(ssq + row, s); }
    } };
struct EpiUp { bf16_t* act; const float* ssq;
    __device__ __forceinline__ void operator()(AccRef acc, const Unit& u, int wr, int wc, int fr, int fq) const {
        const int row0 = u.pm * BM + wr * 64 + fr, col0 = u.pn * BM + wc * 32 + 8 * fq;
        float rr[2][4];
#pragma unroll
        for (int ai = 0; ai < 2; ++ai)
#pragma unroll
            for (int m = 0; m < 4; ++m) rr[ai][m] = ssq[row0 + ai * HALF + m * 16];
#pragma unroll
        for (int ai = 0; ai < 2; ++ai)
#pragma unroll
            for (int m = 0; m < 4; ++m) { const int row = row0 + ai * HALF + m * 16; const float r = rsqrtf(rr[ai][m] * (1.f / DM) + EPS);
#pragma unroll
                for (int bj = 0; bj < 2; ++bj) { f32x4 a = acc[ai][bj][m][0] * r, b = acc[ai][bj][m][1] * r;
#pragma unroll
                    for (int e = 0; e < 4; ++e) { const float ta = fmaxf(a[e], 0.f), tb = fmaxf(b[e], 0.f); a[e] = ta * ta; b[e] = tb * tb; }
                    *(u32x4*)(act + (size_t)row * DFF + col0 + bj * HALF) = pack8(a, b); } }
    } };
struct EpiDown { const bf16_t* h1b; float* h; float* ssq;
    __device__ __forceinline__ void operator()(AccRef acc, const Unit& u, int wr, int wc, int fr, int fq) const {
        const int row0 = u.pm * BM + wr * 64 + fr, col0 = u.pn * BM + wc * 32 + 8 * fq;
#pragma unroll
        for (int ai = 0; ai < 2; ++ai)
#pragma unroll
            for (int m = 0; m < 4; ++m) { const int row = row0 + ai * HALF + m * 16; const size_t off = (size_t)row * DM + col0; float s = 0.f;
#pragma unroll
                for (int bj = 0; bj < 2; ++bj) { const u32x4 hw = *(const u32x4*)(h1b + off + bj * HALF); const f32x4 a = bf4lo(hw) + acc[ai][bj][m][0], b = bf4hi(hw) + acc[ai][bj][m][1];
                    *(f32x4*)(h + off + bj * HALF) = a; *(f32x4*)(h + off + bj * HALF + 4) = b; s += sq4(a) + sq4(b); }
                s = fq_sum(s); if (fq == 0) atomicAdd(ssq + row, s); }
    } };
struct EpiDownFused { const bf16_t* h1b; float* out; const float* gfin; float* xbuf; unsigned* cnt; LAS unsigned char* scr;
    __device__ __forceinline__ void operator()(f32x4 (&acc)[2][2][4][2], const Unit& u, int wr, int wc, int fr, int fq) const {
        LAS float* P = (LAS float*)scr; LAS float* S = (LAS float*)(scr + 4096);
        const int row0 = u.pm * BM + wr * 64 + fr, col0 = u.pn * BM + wc * 32 + 8 * fq;
        u32x4 hw[2][4][2]; f32x4 g[2][2];
#pragma unroll
        for (int ai = 0; ai < 2; ++ai)
#pragma unroll
            for (int m = 0; m < 4; ++m)
#pragma unroll
                for (int bj = 0; bj < 2; ++bj) hw[ai][m][bj] = *(const u32x4*)(h1b + (size_t)(row0 + ai * HALF + m * 16) * DM + col0 + bj * HALF);
#pragma unroll
        for (int bj = 0; bj < 2; ++bj) { g[bj][0] = *(const f32x4*)(gfin + col0 + bj * HALF); g[bj][1] = *(const f32x4*)(gfin + col0 + bj * HALF + 4); }
#pragma unroll
        for (int ai = 0; ai < 2; ++ai)
#pragma unroll
            for (int m = 0; m < 4; ++m) { float s = 0.f;
#pragma unroll
                for (int bj = 0; bj < 2; ++bj) { acc[ai][bj][m][0] += bf4lo(hw[ai][m][bj]); acc[ai][bj][m][1] += bf4hi(hw[ai][m][bj]); s += sq4(acc[ai][bj][m][0]) + sq4(acc[ai][bj][m][1]); }
                s = fq_sum(s); if (fq == 0) P[(ai * HALF + wr * 64 + m * 16 + fr) * 4 + wc] = s; }
        asm volatile("s_waitcnt lgkmcnt(0)\n\ts_barrier" ::: "memory");
        const int t = threadIdx.x;
        if (t < 256) { const float tot = (P[t * 4] + P[t * 4 + 1]) + (P[t * 4 + 2] + P[t * 4 + 3]);
            __hip_atomic_store(xbuf + (size_t)(u.pm * BM + t) * 4 + u.pn, tot, __ATOMIC_RELAXED, __HIP_MEMORY_SCOPE_AGENT); }
        asm volatile("s_waitcnt vmcnt(0)" ::: "memory");
        if (t < 256 && (t & 63) == 0) __hip_atomic_fetch_add(cnt + 64 * u.pm, 1u, __ATOMIC_RELAXED, __HIP_MEMORY_SCOPE_AGENT);
        if (t < 64) { unsigned spins = 0;
            while ((unsigned)__builtin_amdgcn_readfirstlane(__hip_atomic_load(cnt + 64 * u.pm, __ATOMIC_RELAXED, __HIP_MEMORY_SCOPE_AGENT)) < 16u) { __builtin_amdgcn_s_sleep(1); if (++spins > (1u << 22)) break; }
            __builtin_amdgcn_fence(__ATOMIC_ACQUIRE, "agent"); }
        asm volatile("s_waitcnt vmcnt(0) lgkmcnt(0)\n\ts_barrier" ::: "memory");
        if (t < 256) { const float* sl = xbuf + (size_t)(u.pm * BM + t) * 4; float tot = 0.f;
#pragma unroll
            for (int q = 0; q < 4; ++q) tot += __hip_atomic_load(sl + q, __ATOMIC_RELAXED, __HIP_MEMORY_SCOPE_AGENT);
            S[t] = rsqrtf(tot * (1.f / DM) + EPS); }
        asm volatile("s_waitcnt vmcnt(0) lgkmcnt(0)\n\ts_barrier" ::: "memory");
#pragma unroll
        for (int ai = 0; ai < 2; ++ai)
#pragma unroll
            for (int m = 0; m < 4; ++m) { const int rl = ai * HALF + wr * 64 + m * 16 + fr; const float r = S[rl]; const size_t off = (size_t)(u.pm * BM + rl) * DM + col0;
#pragma unroll
                for (int bj = 0; bj < 2; ++bj) { *(f32x4*)(out + off + bj * HALF) = acc[ai][bj][m][0] * g[bj][0] * r; *(f32x4*)(out + off + bj * HALF + 4) = acc[ai][bj][m][1] * g[bj][1] * r; } }
        asm volatile("s_waitcnt lgkmcnt(0)\n\ts_barrier" ::: "memory");
    } };
}

namespace mla {
constexpr int KPITCH = 208, KBUF = 64 * KPITCH, VBUF = 8192;
constexpr int OFF_K = 0, OFF_V = 2 * KBUF, LDS_NEED = 2 * KBUF + 3 * VBUF;
constexpr int NT = SEQ / 64;
constexpr float THR = 8.0f;
constexpr float PTHR = 256.0f;
#define MSB() __builtin_amdgcn_sched_barrier(0)
#define MPIN(x) asm volatile("" : "+v"(x))
#define MX3(a, b, c) __builtin_fmaxf(__builtin_fmaxf((a), (b)), (c))
#define MFMA32(a, b, c) __builtin_amdgcn_mfma_f32_32x32x16_bf16((a), (b), (c), 0, 0, 0)
#define LBAR() do { if (VAR != 1 && VAR != 10 && VAR != 11) asm volatile("s_waitcnt lgkmcnt(0)\n\ts_barrier" ::: "memory"); } while (0)
__device__ __forceinline__ float swapmax(float v) { auto rr = __builtin_amdgcn_permlane32_swap(__float_as_uint(v), __float_as_uint(v), false, false); return __builtin_fmaxf(__uint_as_float(rr[0]), __uint_as_float(rr[1])); }
__device__ __forceinline__ float swapsum(float v) { auto rr = __builtin_amdgcn_permlane32_swap(__float_as_uint(v), __float_as_uint(v), false, false); return __uint_as_float(rr[0]) + __uint_as_float(rr[1]); }
template <int VAR> __device__ __forceinline__ bf16x8 kfrag_(const LAS unsigned char* p, const bf16x8 dummy) { if (VAR == 5 || VAR == 7 || VAR == 10 || VAR == 11) { bf16x8 d = dummy; asm volatile("" : "+v"(d)); return d; } return *(const LAS bf16x8*)p; }
template <int VAR> __device__ __forceinline__ bf16x8 vfrag_(const LAS unsigned char* p, const bf16x8 dummy) { if (VAR == 6 || VAR == 7 || VAR == 10 || VAR == 11) { bf16x8 d = dummy; asm volatile("" : "+v"(d)); return d; } const s16x4 lo = tr16(p), hi = tr16(p + 1024); return __builtin_shufflevector(lo, hi, 0, 1, 2, 3, 4, 5, 6, 7); }
#define kfrag(p) kfrag_<VAR>((p), qr[0])
#define vfrag(p) vfrag_<VAR>((p), qr[1])

__device__ __forceinline__ f32x16 pinacc(f32x16 c, bf16x8 a, bf16x8 b) { asm volatile("" : "+v"(c) : "v"(a), "v"(b)); return c; }
template <int VAR>
__device__ __forceinline__ void unit(LAS unsigned char* lds, int b, int h, int qblk, const bf16_t* __restrict__ Q, const bf16_t* __restrict__ KV, const bf16_t* __restrict__ KPE, bf16_t* __restrict__ O) {
    if (VAR == 12) return;
    constexpr int NT = (VAR == 13) ? mla::NT / 2 : ((VAR == 14) ? 4 : mla::NT);
    const int tid = fresh_tid(), lane = tid & 63, wid = __builtin_amdgcn_readfirstlane(tid >> 6), r32 = lane & 31, hi = lane >> 5;
    const size_t row0 = (size_t)b * SEQ;
    const int srow = tid >> 3, sch = tid & 7;
    const bf16_t* srcA = KV + (row0 + srow) * NKVB + 128 * h + 8 * sch;
    const bf16_t* srcB = srcA + 64;
    const bf16_t* srcC = KPE + (row0 + (tid >> 2)) * 32 + 8 * (tid & 3);
    const int dstA = OFF_K + srow * KPITCH + sch * 16;
    const int dstB = OFF_V + ((srow >> 3) * 2 + (sch >> 2)) * 512 + (srow & 7) * 64 + (sch & 3) * 16;
    const int dstC = OFF_K + (tid >> 2) * KPITCH + 128 + (tid & 3) * 16;
    const bool hasC = tid < 256;
    constexpr size_t TSA = (size_t)64 * NKVB, TSC = (size_t)64 * 32;
    u32x4 a0, b0, c0 = (u32x4){0u, 0u, 0u, 0u}, a1, b1, c1 = (u32x4){0u, 0u, 0u, 0u};
    { const u32x4 ka = *(const u32x4*)srcA; u32x4 kc = (u32x4){0u, 0u, 0u, 0u}; if (hasC) kc = *(const u32x4*)srcC;
      a0 = *(const u32x4*)(srcA + TSA); b0 = *(const u32x4*)srcB; if (hasC) c0 = *(const u32x4*)(srcC + TSC);
      a1 = *(const u32x4*)(srcA + 2 * TSA); b1 = *(const u32x4*)(srcB + TSA); if (hasC) c1 = *(const u32x4*)(srcC + 2 * TSC);
      *(LAS u32x4*)(lds + dstA) = ka; if (hasC) *(LAS u32x4*)(lds + dstC) = kc; }
    const bf16_t* qp = Q + (row0 + qblk * 256 + wid * 32 + r32) * NQB + 96 * h + 8 * hi;
    bf16x8 qr[6];
#pragma unroll
    for (int s = 0; s < 6; ++s) qr[s] = *(const bf16x8*)(qp + 16 * s);
    f32x16 o0, o1, negm, pA0, pA1, pB0, pB1;
#pragma unroll
    for (int i = 0; i < 16; ++i) { o0[i] = 0.f; o1[i] = 0.f; negm[i] = 0.f; }
    MPIN(negm);
    float mref = 0.f, lrun = 0.f, fres = 1.f; bool resc = false;
    const LAS unsigned char* kf0 = lds + OFF_K + r32 * KPITCH + 16 * hi;
    const LAS unsigned char* vf0 = lds + OFF_V + (4 * hi + ((lane & 15) >> 2)) * 64 + ((lane >> 4) & 1) * 32 + (lane & 3) * 8;
    LBAR();
    u32x4 pw0, pw1, pw2, pw3;
#define PKW(P, B) cvtpk(P[B], P[B + 1])
#define PAF(k) __builtin_bit_cast(bf16x8, pw##k)
#define KFC(f) kfrag(kp_ + ((f) & 1) * 32 * KPITCH + 32 * ((f) >> 1))
#define KFN(f) kfrag(kn_ + ((f) & 1) * 32 * KPITCH + 32 * ((f) >> 1))
#define SUM4(P, B) do { if (VAR == 4 || VAR == 10 || VAR == 11) break; sacc += P[B]; sacc += P[B + 1]; sacc += P[B + 2]; sacc += P[B + 3]; MPIN(sacc); } while (0)
#define PK2(PW, i, P, B) do { PW[i] = PKW(P, B); PW[(i) + 1] = PKW(P, (B) + 2); MPIN(PW); } while (0)
#define STAGE_K(SA, SC, s) do { if (VAR == 3 || VAR == 10 || VAR == 11) break; const int kw_ = (((s) + 1) & 1) * KBUF; *(LAS u32x4*)(lds + kw_ + dstA) = SA; if (hasC) *(LAS u32x4*)(lds + kw_ + dstC) = SC; \
        const int tk_ = (s) + 3 < NT ? (s) + 3 : NT - 1; SA = *(const u32x4*)(srcA + (size_t)tk_ * TSA); if (hasC) SC = *(const u32x4*)(srcC + (size_t)tk_ * TSC); } while (0)
#define STAGE_V(SB, s) do { if (VAR == 3 || VAR == 10 || VAR == 11) break; *(LAS u32x4*)(lds + vslot * VBUF + dstB) = SB; const int tv_ = (s) + 2 < NT ? (s) + 2 : NT - 1; SB = *(const u32x4*)(srcB + (size_t)tv_ * TSA); } while (0)
#define DECIDE(C0, C1) do { float a_ = MX3(C0[0], C0[1], C1[0]), b_ = MX3(C0[2], C0[3], C1[1]); a_ = MX3(a_, C1[2], C1[3]); \
        _Pragma("unroll") for (int r = 4; r < 16; r += 4) { a_ = MX3(a_, C0[r], C0[r + 1]); b_ = MX3(b_, C0[r + 2], C0[r + 3]); a_ = MX3(a_, C1[r], C1[r + 1]); b_ = MX3(b_, C1[r + 2], C1[r + 3]); } \
        const float rm_ = swapmax(__builtin_fmaxf(a_, b_)); resc = false; \
        if (__builtin_expect(__any(rm_ > THR), 0)) { const float dl_ = __builtin_fmaxf(rm_, 0.f); mref += dl_; \
            _Pragma("unroll") for (int r = 0; r < 16; ++r) { C0[r] -= dl_; C1[r] -= dl_; } \
            _Pragma("unroll") for (int r = 0; r < 16; ++r) negm[r] = -mref; MPIN(negm); \
            fres = __builtin_amdgcn_exp2f(-dl_); lrun *= fres; resc = true; } } while (0)
#define EXP4(X, B) do { if (VAR == 2 || VAR == 10 || VAR == 11) { MPIN(X); break; } X[B] = __builtin_amdgcn_exp2f(X[B]); X[B + 1] = __builtin_amdgcn_exp2f(X[B + 1]); X[B + 2] = __builtin_amdgcn_exp2f(X[B + 2]); X[B + 3] = __builtin_amdgcn_exp2f(X[B + 3]); MPIN(X); } while (0)
#define LAGDECIDE(P0, P1, N0, N1, M) do { const float rm_ = swapmax(M); resc = false;   \
        if (__builtin_expect(__any(rm_ > PTHR), 0)) { const float dl_ = __builtin_fmaxf(__builtin_amdgcn_logf(rm_), 0.f); fres = __builtin_amdgcn_exp2f(-dl_); mref += dl_; \
            _Pragma("unroll") for (int r = 0; r < 16; ++r) { N0[r] -= dl_; N1[r] -= dl_; negm[r] = -mref; } MPIN(negm); \
            lrun *= fres; resc = true; } } while (0)
#define MFMAB(a, b, c) ((VAR == 8 || VAR == 11) ? pinacc(c, a, b) : MFMA32(a, b, c))
#define MFMAA(a, b, c) ((VAR == 9 || VAR == 11) ? pinacc(c, a, b) : MFMA32(a, b, c))
#define EXP1(X, i) X[i] = __builtin_amdgcn_exp2f(X[i])
#define EXP3(X, a, Y, b, Z, c) do { if (VAR == 2 || VAR == 10 || VAR == 11) { MPIN(X); break; } EXP1(X, a); EXP1(Y, b); EXP1(Z, c); MPIN(X); MPIN(Y); MPIN(Z); } while (0)
#define EXP2(X, a, Y, b) do { if (VAR == 2 || VAR == 10 || VAR == 11) { MPIN(X); break; } EXP1(X, a); EXP1(Y, b); MPIN(X); MPIN(Y); } while (0)
#define STEP(N0, N1, P0, P1, SA, SB, SC, s) do { \
        STAGE_K(SA, SC, s); STAGE_V(SB, s); MSB(); \
        const LAS unsigned char* kp_ = kf0 + ((s) & 1) * KBUF; const LAS unsigned char* kn_ = kf0 + (((s) + 1) & 1) * KBUF; const LAS unsigned char* vp_ = vf0 + vprev * VBUF; \
        bf16x8 v0_, v1_, v2_, v3_; float sacc = 0.f; \
        N0 = MFMAA(k4, qr[2], N0); k4 = KFC(10); SUM4(P0, 0);  PK2(pw0, 0, P0, 0);  MSB(); \
        N1 = MFMAA(k5, qr[2], N1); k5 = KFC(11); SUM4(P0, 4);  PK2(pw0, 2, P0, 4);  MSB(); \
        N0 = MFMAA(k0, qr[3], N0);               SUM4(P0, 8);  PK2(pw1, 0, P0, 8);  MSB(); \
        N1 = MFMAA(k1, qr[3], N1);               SUM4(P0, 12); PK2(pw1, 2, P0, 12); MSB(); \
        N0 = MFMAA(k2, qr[4], N0); v0_ = vfrag(vp_);       SUM4(P1, 0);  PK2(pw2, 0, P1, 0);  MSB(); \
        N1 = MFMAA(k3, qr[4], N1); v1_ = vfrag(vp_ + 512); SUM4(P1, 4);  PK2(pw2, 2, P1, 4);  MSB(); \
        N0 = MFMAA(k4, qr[5], N0); v2_ = vfrag(vp_ + 2048);       SUM4(P1, 8);  PK2(pw3, 0, P1, 8);  MSB(); \
        N1 = MFMAA(k5, qr[5], N1); v3_ = vfrag(vp_ + 2048 + 512); SUM4(P1, 12); PK2(pw3, 2, P1, 12); MSB(); \
        lrun += sacc; \
        LAGDECIDE(P0, P1, N0, N1, sacc); MSB(); \
        LBAR(); \
        vprev = vslot; vslot = (vslot == 2) ? 0 : vslot + 1; \
        k0 = KFN(0); k1 = KFN(1); MSB(); \
        o0 = MFMAB(v0_, PAF(0), o0); v0_ = vfrag(vp_ + 4096);       k2 = KFN(2); EXP3(N0, 0, N0, 1, N0, 2);    MSB(); \
        o1 = MFMAB(v1_, PAF(0), o1); v1_ = vfrag(vp_ + 4096 + 512); k3 = KFN(3); EXP3(N0, 3, N0, 4, N0, 5);    MSB(); \
        o0 = MFMAB(v2_, PAF(1), o0); v2_ = vfrag(vp_ + 6144);       k4 = KFN(4); EXP3(N0, 6, N0, 7, N0, 8);    MSB(); \
        o1 = MFMAB(v3_, PAF(1), o1); v3_ = vfrag(vp_ + 6144 + 512); k5 = KFN(5); EXP3(N0, 9, N0, 10, N0, 11); MSB(); \
        o0 = MFMAB(v0_, PAF(2), o0); EXP3(N0, 12, N0, 13, N0, 14); MSB(); \
        o1 = MFMAB(v1_, PAF(2), o1); EXP3(N0, 15, N1, 0, N1, 1);   MSB(); \
        o0 = MFMAB(v2_, PAF(3), o0); EXP3(N1, 2, N1, 3, N1, 4); MSB(); \
        o1 = MFMAB(v3_, PAF(3), o1); EXP3(N1, 5, N1, 6, N1, 7); MSB(); \
        P0 = MFMAA(k0, qr[0], negm); k0 = KFN(6); EXP2(N1, 8, N1, 9);   MSB(); \
        P1 = MFMAA(k1, qr[0], negm); k1 = KFN(7); EXP2(N1, 10, N1, 11); MSB(); \
        P0 = MFMAA(k2, qr[1], P0);   k2 = KFN(8); EXP2(N1, 12, N1, 13); MSB(); \
        P1 = MFMAA(k3, qr[1], P1);   k3 = KFN(9); EXP2(N1, 14, N1, 15); MSB(); \
        if (resc) { _Pragma("unroll") for (int r = 0; r < 16; ++r) { o0[r] *= fres; o1[r] *= fres; } } \
        } while (0)
#define QK2(C0, C1, ds, INIT) do { const bf16x8 ka_ = kfrag(kp_ + 32 * (ds)), kb_ = kfrag(kp_ + 32 * KPITCH + 32 * (ds)); \
        C0 = MFMA32(ka_, qr[ds], INIT ? negm : C0); C1 = MFMA32(kb_, qr[ds], INIT ? negm : C1); } while (0)
    bf16x8 k0, k1, k2, k3, k4, k5;
    int vslot = 0, vprev = 0;
    {
        STAGE_K(a0, c0, 0); STAGE_V(b0, 0); MSB();
        const LAS unsigned char* kp_ = kf0; const LAS unsigned char* kn_ = kf0 + KBUF;
        QK2(pA0, pA1, 0, true); QK2(pA0, pA1, 1, false); QK2(pA0, pA1, 2, false); QK2(pA0, pA1, 3, false); QK2(pA0, pA1, 4, false); QK2(pA0, pA1, 5, false);
        float a_ = MX3(pA0[0], pA0[1], pA1[0]), b_ = MX3(pA0[2], pA0[3], pA1[1]); a_ = MX3(a_, pA1[2], pA1[3]);
#pragma unroll
        for (int r = 4; r < 16; r += 4) { a_ = MX3(a_, pA0[r], pA0[r + 1]); b_ = MX3(b_, pA0[r + 2], pA0[r + 3]); a_ = MX3(a_, pA1[r], pA1[r + 1]); b_ = MX3(b_, pA1[r + 2], pA1[r + 3]); }
        const float rm_ = swapmax(__builtin_fmaxf(a_, b_));
        mref = rm_;
#pragma unroll
        for (int r = 0; r < 16; ++r) { pA0[r] = __builtin_amdgcn_exp2f(pA0[r] - rm_); pA1[r] = __builtin_amdgcn_exp2f(pA1[r] - rm_); negm[r] = -mref; }
        MPIN(negm);
        LBAR();
        vprev = vslot; vslot = 1;
        k0 = KFN(0); k1 = KFN(1); k2 = KFN(2); k3 = KFN(3); k4 = KFN(4); k5 = KFN(5);
        pB0 = MFMA32(k0, qr[0], negm); pB1 = MFMA32(k1, qr[0], negm); pB0 = MFMA32(k2, qr[1], pB0); pB1 = MFMA32(k3, qr[1], pB1);
        k0 = KFN(6); k1 = KFN(7); k2 = KFN(8); k3 = KFN(9);
    }
    for (int s = 1; s + 1 < NT; s += 2) {
        STEP(pB0, pB1, pA0, pA1, a1, b1, c1, s);
        STEP(pA0, pA1, pB0, pB1, a0, b0, c0, s + 1);
    }
    STEP(pB0, pB1, pA0, pA1, a1, b1, c1, NT - 1);
    LBAR();
    {
        float sacc = 0.f;
#pragma unroll
        for (int r = 0; r < 16; ++r) sacc += pB0[r] + pB1[r];
        lrun += sacc;
        pw0 = (u32x4){PKW(pB0, 0), PKW(pB0, 2), PKW(pB0, 4), PKW(pB0, 6)}; pw1 = (u32x4){PKW(pB0, 8), PKW(pB0, 10), PKW(pB0, 12), PKW(pB0, 14)};
        pw2 = (u32x4){PKW(pB1, 0), PKW(pB1, 2), PKW(pB1, 4), PKW(pB1, 6)}; pw3 = (u32x4){PKW(pB1, 8), PKW(pB1, 10), PKW(pB1, 12), PKW(pB1, 14)};
        const LAS unsigned char* vp_ = vf0 + vprev * VBUF;
        { const bf16x8 v0_ = vfrag(vp_), v1_ = vfrag(vp_ + 512); o0 = MFMA32(v0_, PAF(0), o0); o1 = MFMA32(v1_, PAF(0), o1); }
        { const bf16x8 v0_ = vfrag(vp_ + 2048), v1_ = vfrag(vp_ + 2048 + 512); o0 = MFMA32(v0_, PAF(1), o0); o1 = MFMA32(v1_, PAF(1), o1); }
        { const bf16x8 v0_ = vfrag(vp_ + 4096), v1_ = vfrag(vp_ + 4096 + 512); o0 = MFMA32(v0_, PAF(2), o0); o1 = MFMA32(v1_, PAF(2), o1); }
        { const bf16x8 v0_ = vfrag(vp_ + 6144), v1_ = vfrag(vp_ + 6144 + 512); o0 = MFMA32(v0_, PAF(3), o0); o1 = MFMA32(v1_, PAF(3), o1); }
    }
    lrun = swapsum(lrun);
    const float inv = 1.f / lrun;
    bf16_t* op = O + (row0 + qblk * 256 + wid * 32 + r32) * DM + 512 + 64 * h + 4 * hi;
#pragma unroll
    for (int i = 0; i < 4; ++i) {
        u32x2 w; w.x = cvtpk(o0[4 * i] * inv, o0[4 * i + 1] * inv); w.y = cvtpk(o0[4 * i + 2] * inv, o0[4 * i + 3] * inv); *(u32x2*)(op + 8 * i) = w;
        u32x2 z; z.x = cvtpk(o1[4 * i] * inv, o1[4 * i + 1] * inv); z.y = cvtpk(o1[4 * i + 2] * inv, o1[4 * i + 3] * inv); *(u32x2*)(op + 32 + 8 * i) = z;
    }
    LBAR();
#undef PKW
#undef PAF
#undef STAGE_K
#undef STAGE_V
#undef QK2
#undef SUM4
#undef PK2
#undef KFC
#undef KFN
#undef DECIDE
#undef LAGDECIDE
#undef EXP4
#undef EXP1
#undef EXP2
#undef EXP3
#undef STEP
}
#undef kfrag
#undef vfrag
#undef MSB
#undef MPIN
#undef MX3
#undef MFMA32
#undef LBAR
}

namespace dil {
constexpr int EXT_OFF1 = 176, EXT_OFF2 = 428, EXT_H = 1052;
constexpr float THR = 8.0f;
constexpr int ROWB = NPROJ * 2;
__device__ __forceinline__ void build_ext(LAS float* ext, const float* __restrict__ rel_bias) {
    for (int i = threadIdx.x; i < 8 * EXT_H; i += NTHREADS) { const int h = i / EXT_H, k = i % EXT_H;
        int d, j; if (k < EXT_OFF1) { d = 16; j = k - 79; } else if (k < EXT_OFF2) { d = 4; j = k - EXT_OFF1 - 124; } else { d = 1; j = k - EXT_OFF2 - 304; }
        ext[i] = (j >= -64 && j <= 64) ? rel_bias[t5_bucket(d * j) * 8 + h] * LOG2E : -__builtin_inff(); }
}
struct Frags { u32x4 k0, k1, k2, k3; u32x4 v0, v1, v2, v3; };
template <int LD>
struct Pat {
    static constexpr int D = 1 << LD, QS = 16 >> LD, LMAX = SEQ >> LD;
    static __device__ __forceinline__ void load(Frags& f, const bf16_t* __restrict__ prow, int Lb, int rem, int c, unsigned offK, unsigned offV, int vrow, unsigned kcol, unsigned vcol) {
        const int lbase = Lb - 64 + 32 * c;
        if (lbase >= 0 && lbase + 31 < LMAX) {
            const char* ub = (const char*)prow + (size_t)((lbase << LD) + rem) * ROWB;
            constexpr size_t R8 = (size_t)(8 << LD) * ROWB;
            f.k0 = *(const u32x4*)(ub + offK); f.k1 = *(const u32x4*)(ub + offK + R8); f.k2 = *(const u32x4*)(ub + offK + 2 * R8); f.k3 = *(const u32x4*)(ub + offK + 3 * R8);
            f.v0 = *(const u32x4*)(ub + offV); f.v1 = *(const u32x4*)(ub + offV + R8); f.v2 = *(const u32x4*)(ub + offV + 2 * R8); f.v3 = *(const u32x4*)(ub + offV + 3 * R8);
        } else {
            auto rowp = [&](int l) { l = l < 0 ? 0 : (l > LMAX - 1 ? LMAX - 1 : l); return (const char*)prow + (size_t)((l << LD) + rem) * ROWB; };
            const char* r0 = rowp(lbase + vrow); const char* r1 = rowp(lbase + vrow + 8); const char* r2 = rowp(lbase + vrow + 16); const char* r3 = rowp(lbase + vrow + 24);
            f.k0 = *(const u32x4*)(r0 + kcol); f.k1 = *(const u32x4*)(r1 + kcol); f.k2 = *(const u32x4*)(r2 + kcol); f.k3 = *(const u32x4*)(r3 + kcol);
            f.v0 = *(const u32x4*)(r0 + vcol); f.v1 = *(const u32x4*)(r1 + vcol); f.v2 = *(const u32x4*)(r2 + vcol); f.v3 = *(const u32x4*)(r3 + vcol);
        }
    }
    static __device__ __forceinline__ void compute(const Frags& f, LAS unsigned char* kw, LAS unsigned char* kwx, const LAS unsigned char* kr, const LAS unsigned char* krx, LAS unsigned char* vw, const LAS unsigned char* (&vr)[4], const LAS float* tb, int Lb, int c, int fq, const bf16x8 (&qf)[2], f32x4 (&oacc)[4], float& mref, float& lrun) {
        const int lbase = Lb - 64 + 32 * c;
        *(LAS u32x4*)(kw) = f.k0; *(LAS u32x4*)(kwx + 8 * 128) = f.k1; *(LAS u32x4*)(kw + 16 * 128) = f.k2; *(LAS u32x4*)(kwx + 24 * 128) = f.k3;
        *(LAS u32x4*)(vw) = f.v0; *(LAS u32x4*)(vw + 8 * 32) = f.v1; *(LAS u32x4*)(vw + 16 * 32) = f.v2; *(LAS u32x4*)(vw + 24 * 32) = f.v3;
        const LAS float* t = tb + 32 * c;
        f32x4 sa = {t[0], t[1], t[2], t[3]}, sb = {t[16], t[17], t[18], t[19]};
        if (!(lbase >= 0 && lbase + 31 < LMAX)) {
            const float NEG = -__builtin_inff();
#pragma unroll
            for (int e = 0; e < 4; ++e) { const int la = lbase + 4 * fq + e, lb2 = la + 16; if (la < 0 || la >= LMAX) sa[e] = NEG; if (lb2 < 0 || lb2 >= LMAX) sb[e] = NEG; }
        }
        const bf16x8 k00 = *(const LAS bf16x8*)kr, k01 = *(const LAS bf16x8*)krx, k10 = *(const LAS bf16x8*)(kr + 16 * 128), k11 = *(const LAS bf16x8*)(krx + 16 * 128);
        sa = __builtin_amdgcn_mfma_f32_16x16x32_bf16(k00, qf[0], sa, 0, 0, 0); sa = __builtin_amdgcn_mfma_f32_16x16x32_bf16(k01, qf[1], sa, 0, 0, 0);
        sb = __builtin_amdgcn_mfma_f32_16x16x32_bf16(k10, qf[0], sb, 0, 0, 0); sb = __builtin_amdgcn_mfma_f32_16x16x32_bf16(k11, qf[1], sb, 0, 0, 0);
        const float lm = __builtin_fmaxf(__builtin_fmaxf(__builtin_fmaxf(sa[0], sa[1]), __builtin_fmaxf(sa[2], sa[3])), __builtin_fmaxf(__builtin_fmaxf(sb[0], sb[1]), __builtin_fmaxf(sb[2], sb[3])));
        if (__any(lm > mref + THR)) {
            float rm = __builtin_fmaxf(lm, __shfl_xor(lm, 16)); rm = __builtin_fmaxf(rm, __shfl_xor(rm, 32));
            const float mnew = __builtin_fmaxf(mref, rm), alpha = __builtin_amdgcn_exp2f(mref - mnew);
            lrun *= alpha;
#pragma unroll
            for (int d = 0; d < 4; ++d) oacc[d] = oacc[d] * alpha;
            mref = mnew;
        }
        float ls = 0.f;
#pragma unroll
        for (int e = 0; e < 4; ++e) { sa[e] = __builtin_amdgcn_exp2f(sa[e] - mref); sb[e] = __builtin_amdgcn_exp2f(sb[e] - mref); ls += sa[e] + sb[e]; }
        lrun += ls;
        u32x4 pw; pw.x = cvtpk(sa[0], sa[1]); pw.y = cvtpk(sa[2], sa[3]); pw.z = cvtpk(sb[0], sb[1]); pw.w = cvtpk(sb[2], sb[3]);
        const bf16x8 pk = __builtin_bit_cast(bf16x8, pw);
#pragma unroll
        for (int d = 0; d < 4; ++d) { const s16x4 lo = tr16(vr[d]), hi = tr16(vr[d] + 512);
            const bf16x8 va = __builtin_shufflevector(lo, hi, 0, 1, 2, 3, 4, 5, 6, 7);
            oacc[d] = __builtin_amdgcn_mfma_f32_16x16x32_bf16(va, pk, oacc[d], 0, 0, 0); }
    }
    template <int NSTEP>
    static __device__ __forceinline__ void run(LAS unsigned char* kw, LAS unsigned char* kwx, const LAS unsigned char* kr, const LAS unsigned char* krx, LAS unsigned char* vw, const LAS unsigned char* (&vr)[4], const LAS float* ext_h, const bf16_t* __restrict__ prow, int t0, int lane, unsigned kcol, unsigned vcol, const bf16x8 (&qf)[2], f32x4 (&oacc)[4], float& mref, float& lrun) {
        const int i16 = lane & 15, fq = lane >> 4, vrow = lane >> 3;
        const int Lb = __builtin_amdgcn_readfirstlane(t0 >> LD), rem = __builtin_amdgcn_readfirstlane(t0 & (D - 1));
        const unsigned offK = (unsigned)(vrow << LD) * ROWB + kcol, offV = (unsigned)(vrow << LD) * ROWB + vcol;
        const LAS float* tb = ext_h + (LD == 4 ? 0 : (LD == 2 ? EXT_OFF1 : EXT_OFF2)) + 15 * QS + 4 * fq - QS * i16;
        Frags A, B;
        load(A, prow, Lb, rem, 0, offK, offV, vrow, kcol, vcol);
        int c = 0;
#pragma unroll 1
        for (; c + 1 < NSTEP; c += 2) {
            load(B, prow, Lb, rem, c + 1, offK, offV, vrow, kcol, vcol);
            compute(A, kw, kwx, kr, krx, vw, vr, tb, Lb, c, fq, qf, oacc, mref, lrun);
            if (c + 2 < NSTEP) load(A, prow, Lb, rem, c + 2, offK, offV, vrow, kcol, vcol);
            compute(B, kw, kwx, kr, krx, vw, vr, tb, Lb, c + 1, fq, qf, oacc, mref, lrun);
        }
        if (NSTEP & 1) compute(A, kw, kwx, kr, krx, vw, vr, tb, Lb, NSTEP - 1, fq, qf, oacc, mref, lrun);
    }
};
constexpr int SH_PITCH = 160, SH_TILE = 40 * SH_PITCH, SH_BUF = 2 * SH_TILE;
template <int DV>
__device__ __forceinline__ void p1_shared(LAS unsigned char* sh, const LAS float* ext_h, const bf16_t* __restrict__ prow, int h, int T, int w, int lane, const bf16x8 (&qf)[2], f32x4 (&oacc)[4], float& mref, float& lrun) {
    constexpr int NSTEP = (DV == 6) ? 6 : 12;
    const int tid = threadIdx.x, i16 = lane & 15, fq = lane >> 4;
    const int r0 = tid >> 4, c0 = tid & 15; const bool two = tid < 128; const int r1 = (tid + 512) >> 4;
    const unsigned col0 = (unsigned)((c0 < 8 ? COL_KA : COL_VA - 64) + 64 * h + 8 * c0) * 2u;
    const int d0 = (c0 < 8 ? 0 : SH_TILE) + r0 * SH_PITCH + (c0 & 7) * 16, d1 = (c0 < 8 ? 0 : SH_TILE) + r1 * SH_PITCH + (c0 & 7) * 16;
    auto ld = [&](int c, int row) { int p = T - 64 + 32 * c + row; p = p < 0 ? 0 : (p > SEQ - 1 ? SEQ - 1 : p); return *(const u32x4*)((const char*)prow + (size_t)p * ROWB + col0); };
    u32x4 ga = ld(0, r0), gb = (u32x4){0u, 0u, 0u, 0u}, ha, hb = (u32x4){0u, 0u, 0u, 0u}; if (two) gb = ld(0, r1);
    __syncthreads();
    *(LAS u32x4*)(sh + d0) = ga; if (two) *(LAS u32x4*)(sh + d1) = gb;
    ga = ld(1, r0); if (two) gb = ld(1, r1);
    ha = ld(2, r0); if (two) hb = ld(2, r1);
    const LAS float* tb = ext_h + EXT_OFF2 + 15 * 16 + 4 * fq - 16 * i16;
    const int kro = (w + i16) * SH_PITCH + fq * 16, vro = SH_TILE + (w + 4 * fq + (i16 >> 2)) * SH_PITCH + (i16 & 3) * 8;
    asm volatile("s_waitcnt lgkmcnt(0)\n\ts_barrier" ::: "memory");
#pragma unroll 1
    for (int c = 0; c < NSTEP; ++c) {
        const LAS unsigned char* bufp = sh + (c & 1) * SH_BUF;
        const int lbase = T + w - 64 + 32 * c;
        const LAS float* t = tb + 32 * c;
        f32x4 sa = {t[0], t[1], t[2], t[3]}, sb = {t[16], t[17], t[18], t[19]};
        if (!(lbase >= 0 && lbase + 31 < SEQ)) { const float NEG = -__builtin_inff();
#pragma unroll
            for (int e = 0; e < 4; ++e) { const int la = lbase + 4 * fq + e, lb2 = la + 16; if (la < 0 || la >= SEQ) sa[e] = NEG; if (lb2 < 0 || lb2 >= SEQ) sb[e] = NEG; } }
        const bf16x8 k00 = *(const LAS bf16x8*)(bufp + kro), k01 = *(const LAS bf16x8*)(bufp + kro + 64), k10 = *(const LAS bf16x8*)(bufp + kro + 16 * SH_PITCH), k11 = *(const LAS bf16x8*)(bufp + kro + 16 * SH_PITCH + 64);
        sa = __builtin_amdgcn_mfma_f32_16x16x32_bf16(k00, qf[0], sa, 0, 0, 0); sa = __builtin_amdgcn_mfma_f32_16x16x32_bf16(k01, qf[1], sa, 0, 0, 0);
        sb = __builtin_amdgcn_mfma_f32_16x16x32_bf16(k10, qf[0], sb, 0, 0, 0); sb = __builtin_amdgcn_mfma_f32_16x16x32_bf16(k11, qf[1], sb, 0, 0, 0);
        if (DV == 5) { lrun += sa[0] + sb[0]; } else {
        const float lm = __builtin_fmaxf(__builtin_fmaxf(__builtin_fmaxf(sa[0], sa[1]), __builtin_fmaxf(sa[2], sa[3])), __builtin_fmaxf(__builtin_fmaxf(sb[0], sb[1]), __builtin_fmaxf(sb[2], sb[3])));
        if (__any(lm > mref + THR)) {
            float rm = __builtin_fmaxf(lm, __shfl_xor(lm, 16)); rm = __builtin_fmaxf(rm, __shfl_xor(rm, 32));
            const float mnew = __builtin_fmaxf(mref, rm), alpha = __builtin_amdgcn_exp2f(mref - mnew);
            lrun *= alpha;
#pragma unroll
            for (int d = 0; d < 4; ++d) oacc[d] = oacc[d] * alpha;
            mref = mnew;
        }
        float ls = 0.f;
#pragma unroll
        for (int e = 0; e < 4; ++e) { sa[e] = __builtin_amdgcn_exp2f(sa[e] - mref); sb[e] = __builtin_amdgcn_exp2f(sb[e] - mref); ls += sa[e] + sb[e]; }
        lrun += ls;
        u32x4 pw; pw.x = cvtpk(sa[0], sa[1]); pw.y = cvtpk(sa[2], sa[3]); pw.z = cvtpk(sb[0], sb[1]); pw.w = cvtpk(sb[2], sb[3]);
        const bf16x8 pk = __builtin_bit_cast(bf16x8, pw);
#pragma unroll
        for (int d = 0; d < 4; ++d) { const s16x4 lo = tr16(bufp + vro + d * 32), hi = tr16(bufp + vro + d * 32 + 16 * SH_PITCH);
            const bf16x8 va = __builtin_shufflevector(lo, hi, 0, 1, 2, 3, 4, 5, 6, 7);
            oacc[d] = __builtin_amdgcn_mfma_f32_16x16x32_bf16(va, pk, oacc[d], 0, 0, 0); }
        }
        if (DV != 4 && c + 1 < NSTEP) { LAS unsigned char* nb = sh + ((c + 1) & 1) * SH_BUF; *(LAS u32x4*)(nb + d0) = ga; if (two) *(LAS u32x4*)(nb + d1) = gb;
            ga = ha; gb = hb; const int cn = c + 3 < NSTEP ? c + 3 : NSTEP - 1; ha = ld(cn, r0); if (two) hb = ld(cn, r1); }
        if (DV != 4) asm volatile("s_waitcnt lgkmcnt(0)\n\ts_barrier" ::: "memory");
    }
}
template <bool SHARED, int DV>
__device__ __forceinline__ void item(LAS unsigned char* vst, const LAS float* ext, LAS unsigned char* sh, int wv, int b, int h, int blk, int r, const bf16_t* __restrict__ proj, bf16_t* __restrict__ O, int lane) {
    const int i16 = lane & 15, fq = lane >> 4, t0 = 256 * blk + r, vrow = lane >> 3, vch = lane & 7;
    const bf16_t* prow = proj + (size_t)b * SEQ * NPROJ;
    const int qpos = t0 + 16 * i16;
    const bf16_t* qp = prow + (size_t)qpos * NPROJ + COL_QA + 64 * h + 8 * fq;
    bf16x8 qf[2]; qf[0] = *(const bf16x8*)qp; qf[1] = *(const bf16x8*)(qp + 32);
    const unsigned kcol = (unsigned)(COL_KA + 64 * h + 8 * vch) * 2u, vcol = (unsigned)(COL_VA + 64 * h + 8 * vch) * 2u;
    LAS unsigned char* ktile = vst + 4096;
    LAS unsigned char* kw = ktile + vrow * 128 + ((vch ^ ((vrow >> 1) & 7)) * 16); LAS unsigned char* kwx = ktile + vrow * 128 + ((vch ^ ((vrow >> 1) & 7) ^ 4) * 16);
    const LAS unsigned char* kr = ktile + i16 * 128 + ((fq ^ ((i16 >> 1) & 7)) * 16); const LAS unsigned char* krx = ktile + i16 * 128 + (((fq + 4) ^ ((i16 >> 1) & 7)) * 16);
    LAS unsigned char* vw = vst + (vch >> 1) * 1024 + ((vrow ^ (vch >> 1)) * 32) + (vch & 1) * 16;
    const LAS unsigned char* vr[4];
#pragma unroll
    for (int d = 0; d < 4; ++d) vr[d] = vst + d * 1024 + (4 * fq + ((i16 >> 2) ^ d)) * 32 + (i16 & 3) * 8;
    f32x4 oacc[4];
#pragma unroll
    for (int d = 0; d < 4; ++d) oacc[d] = (f32x4){0.f, 0.f, 0.f, 0.f};
    float mref = -1.0e30f, lrun = 0.f;
    const LAS float* ext_h = ext + h * EXT_H;
    if (DV == 0 || DV == 1) Pat<4>::run<5>(kw, kwx, kr, krx, vw, vr, ext_h, prow, t0, lane, kcol, vcol, qf, oacc, mref, lrun);
    if (DV == 0 || DV == 1) Pat<2>::run<6>(kw, kwx, kr, krx, vw, vr, ext_h, prow, t0, lane, kcol, vcol, qf, oacc, mref, lrun);
    if (DV == 1 || DV == 3) {} else if (SHARED) p1_shared<DV>(sh, ext_h, prow, h, t0 - wv, wv, lane, qf, oacc, mref, lrun);
    else Pat<0>::run<12>(kw, kwx, kr, krx, vw, vr, ext_h, prow, t0, lane, kcol, vcol, qf, oacc, mref, lrun);
    lrun = pg8::fq_sum(lrun);
    const float inv = 1.f / lrun;
    bf16_t* op = O + ((size_t)b * SEQ + qpos) * DM + 64 * h + 4 * fq;
#pragma unroll
    for (int d = 0; d < 4; ++d) { u32x2 w; w.x = cvtpk(oacc[d][0] * inv, oacc[d][1] * inv); w.y = cvtpk(oacc[d][2] * inv, oacc[d][3] * inv); *(u32x2*)(op + 16 * d) = w; }
}
}

namespace dil2 {
using dil::Frags; using dil::EXT_OFF1; using dil::EXT_OFF2; using dil::EXT_H; using dil::THR; using dil::ROWB;
constexpr int WTILE = 16384;
constexpr int SH_PITCH = 160, SH_ROWS = 48, SH_TILE = SH_ROWS * SH_PITCH, SH_BUF = 2 * SH_TILE;
struct St { bf16x8 q0, q1; f32x4 o0, o1, o2, o3; float mref, lrun; };
constexpr int T2_OFF1 = 176, T2_OFFC = 428, T2_H = 604;
__device__ __forceinline__ void build_ext_all(LAS float* ext4, const float* __restrict__ rel_bias, int hpar) {
    for (int idx = threadIdx.x; idx < 4 * T2_H; idx += NTHREADS) { const int i = idx / T2_H, k = idx % T2_H, h = 2 * i + hpar; int d, j;
        if (k < T2_OFF1) { d = 16; j = k - 79; } else if (k < T2_OFFC) { d = 4; j = k - T2_OFF1 - 124; } else { d = 1; j = k - T2_OFFC - 79; }
        ext4[idx] = (j >= -64 && j <= 64) ? rel_bias[t5_bucket(d * j) * 8 + h] * LOG2E : -__builtin_inff(); }
}
__device__ __forceinline__ void build_ext_h(LAS float* ext, const float* __restrict__ rel_bias, int h) {
    for (int k = threadIdx.x; k < EXT_H + 176; k += NTHREADS) { int d, j; if (k < EXT_OFF1) { d = 16; j = k - 79; } else if (k < EXT_OFF2) { d = 4; j = k - EXT_OFF1 - 124; } else if (k < EXT_H) { d = 1; j = k - EXT_OFF2 - 304; } else { d = 1; j = k - EXT_H - 79; }
        ext[k] = (j >= -64 && j <= 64) ? rel_bias[t5_bucket(d * j) * 8 + h] * LOG2E : -__builtin_inff(); }
}
__device__ __forceinline__ float lanemax8(const f32x4 a, const f32x4 b) { return __builtin_fmaxf(__builtin_fmaxf(__builtin_fmaxf(a[0], a[1]), __builtin_fmaxf(a[2], a[3])), __builtin_fmaxf(__builtin_fmaxf(b[0], b[1]), __builtin_fmaxf(b[2], b[3]))); }
__device__ __forceinline__ void refresh(St& s, float lm) {
    float rm = __builtin_fmaxf(lm, __shfl_xor(lm, 16)); rm = __builtin_fmaxf(rm, __shfl_xor(rm, 32));
    const float mnew = __builtin_fmaxf(s.mref, rm), alpha = __builtin_amdgcn_exp2f(s.mref - mnew);
    s.lrun *= alpha; s.o0 = s.o0 * alpha; s.o1 = s.o1 * alpha; s.o2 = s.o2 * alpha; s.o3 = s.o3 * alpha; s.mref = mnew;
}
#ifndef DIL2_EXP
#define DIL2_EXP(x) __builtin_amdgcn_exp2f(x)
#endif
__device__ __forceinline__ bf16x8 expsum(St& s, f32x4 sa, f32x4 sb) {
    float ls = 0.f;
#pragma unroll
    for (int e = 0; e < 4; ++e) { sa[e] = DIL2_EXP(sa[e] - s.mref); sb[e] = DIL2_EXP(sb[e] - s.mref); ls += sa[e] + sb[e]; }
    s.lrun += ls;
    u32x4 pw; pw.x = cvtpk(sa[0], sa[1]); pw.y = cvtpk(sa[2], sa[3]); pw.z = cvtpk(sb[0], sb[1]); pw.w = cvtpk(sb[2], sb[3]);
    return __builtin_bit_cast(bf16x8, pw);
}
__device__ __forceinline__ void maskrows(f32x4& sa, f32x4& sb, int lbase, int fq, int lmax) {
    const float NEG = -__builtin_inff();
#pragma unroll
    for (int e = 0; e < 4; ++e) { const int la = lbase + 4 * fq + e, lb2 = la + 16; if (la < 0 || la >= lmax) sa[e] = NEG; if (lb2 < 0 || lb2 >= lmax) sb[e] = NEG; }
}
#define MF16(a, b, c) __builtin_amdgcn_mfma_f32_16x16x32_bf16((a), (b), (c), 0, 0, 0)
#define VFR(p) __builtin_shufflevector(tr16(p), tr16((p) + VHI), 0, 1, 2, 3, 4, 5, 6, 7)
__device__ __forceinline__ void soft2(St& A, St& B, f32x4 sa0, f32x4 sb0, f32x4 sa1, f32x4 sb1, bf16x8& pkA, bf16x8& pkB) {
    const float lmA = lanemax8(sa0, sb0), lmB = lanemax8(sa1, sb1);
    if (__any((lmA > A.mref + THR) || (lmB > B.mref + THR))) { refresh(A, lmA); refresh(B, lmB); }
    pkA = expsum(A, sa0, sb0); pkB = expsum(B, sa1, sb1);
}
struct Addr { LAS unsigned char *kw, *kwx, *vw; const LAS unsigned char *kr, *krx, *vr0, *vr1, *vr2, *vr3; };
template <int LD>
struct Pat2 {
    static constexpr int D = 1 << LD, QS = 16 >> LD, LMAX = SEQ >> LD, DB = 8 >> LD, REMB = (LD == 4) ? 8 : 0;
    static __device__ __forceinline__ void load(Frags& fa, Frags& fb, const bf16_t* __restrict__ prow, int Lb, int rem, int c, unsigned offK, unsigned offV, int vrow, unsigned kcol, unsigned vcol) {
        const int lbase = Lb - 64 + 32 * c;
        constexpr size_t R8 = (size_t)(8 << LD) * ROWB;
        if (lbase >= 0 && lbase + DB + 31 < LMAX) {
            const char* ua = (const char*)prow + (size_t)((lbase << LD) + rem) * ROWB; const char* ub = ua + 8 * ROWB;
            fa.k0 = *(const u32x4*)(ua + offK); fa.k1 = *(const u32x4*)(ua + offK + R8); fa.k2 = *(const u32x4*)(ua + offK + 2 * R8); fa.k3 = *(const u32x4*)(ua + offK + 3 * R8);
            fa.v0 = *(const u32x4*)(ua + offV); fa.v1 = *(const u32x4*)(ua + offV + R8); fa.v2 = *(const u32x4*)(ua + offV + 2 * R8); fa.v3 = *(const u32x4*)(ua + offV + 3 * R8);
            fb.k0 = *(const u32x4*)(ub + offK); fb.k1 = *(const u32x4*)(ub + offK + R8); fb.k2 = *(const u32x4*)(ub + offK + 2 * R8); fb.k3 = *(const u32x4*)(ub + offK + 3 * R8);
            fb.v0 = *(const u32x4*)(ub + offV); fb.v1 = *(const u32x4*)(ub + offV + R8); fb.v2 = *(const u32x4*)(ub + offV + 2 * R8); fb.v3 = *(const u32x4*)(ub + offV + 3 * R8);
        } else {
            auto rowp = [&](int l, int rm) { l = l < 0 ? 0 : (l > LMAX - 1 ? LMAX - 1 : l); return (const char*)prow + (size_t)((l << LD) + rm) * ROWB; };
            { const char* r0 = rowp(lbase + vrow, rem); const char* r1 = rowp(lbase + vrow + 8, rem); const char* r2 = rowp(lbase + vrow + 16, rem); const char* r3 = rowp(lbase + vrow + 24, rem);
              fa.k0 = *(const u32x4*)(r0 + kcol); fa.k1 = *(const u32x4*)(r1 + kcol); fa.k2 = *(const u32x4*)(r2 + kcol); fa.k3 = *(const u32x4*)(r3 + kcol);
              fa.v0 = *(const u32x4*)(r0 + vcol); fa.v1 = *(const u32x4*)(r1 + vcol); fa.v2 = *(const u32x4*)(r2 + vcol); fa.v3 = *(const u32x4*)(r3 + vcol); }
            { const int lb = lbase + DB, rb = rem + REMB;
              const char* r0 = rowp(lb + vrow, rb); const char* r1 = rowp(lb + vrow + 8, rb); const char* r2 = rowp(lb + vrow + 16, rb); const char* r3 = rowp(lb + vrow + 24, rb);
              fb.k0 = *(const u32x4*)(r0 + kcol); fb.k1 = *(const u32x4*)(r1 + kcol); fb.k2 = *(const u32x4*)(r2 + kcol); fb.k3 = *(const u32x4*)(r3 + kcol);
              fb.v0 = *(const u32x4*)(r0 + vcol); fb.v1 = *(const u32x4*)(r1 + vcol); fb.v2 = *(const u32x4*)(r2 + vcol); fb.v3 = *(const u32x4*)(r3 + vcol); }
        }
    }
    static __device__ __forceinline__ void stage(const Frags& fa, const Frags& fb, const Addr& a) {
        constexpr int BO = 8192;
        *(LAS u32x4*)(a.kw) = fa.k0; *(LAS u32x4*)(a.kwx + 8 * 128) = fa.k1; *(LAS u32x4*)(a.kw + 16 * 128) = fa.k2; *(LAS u32x4*)(a.kwx + 24 * 128) = fa.k3;
        *(LAS u32x4*)(a.kw + BO) = fb.k0; *(LAS u32x4*)(a.kwx + BO + 8 * 128) = fb.k1; *(LAS u32x4*)(a.kw + BO + 16 * 128) = fb.k2; *(LAS u32x4*)(a.kwx + BO + 24 * 128) = fb.k3;
        *(LAS u32x4*)(a.vw) = fa.v0; *(LAS u32x4*)(a.vw + 8 * 32) = fa.v1; *(LAS u32x4*)(a.vw + 16 * 32) = fa.v2; *(LAS u32x4*)(a.vw + 24 * 32) = fa.v3;
        *(LAS u32x4*)(a.vw + BO) = fb.v0; *(LAS u32x4*)(a.vw + BO + 8 * 32) = fb.v1; *(LAS u32x4*)(a.vw + BO + 16 * 32) = fb.v2; *(LAS u32x4*)(a.vw + BO + 24 * 32) = fb.v3;
    }
    static __device__ __forceinline__ void core(const Addr& a, const LAS float* tb, int Lb, int c, int fq, St& A, St& B) {
        constexpr int BO = 8192, VHI = 512;
        const int lbase = Lb - 64 + 32 * c;
        const LAS float* t = tb + 32 * c;
        f32x4 sa0 = {t[0], t[1], t[2], t[3]}, sb0 = {t[16], t[17], t[18], t[19]}, sa1 = sa0, sb1 = sb0;
        if (!(lbase >= 0 && lbase + DB + 31 < LMAX)) { maskrows(sa0, sb0, lbase, fq, LMAX); maskrows(sa1, sb1, lbase + DB, fq, LMAX); }
        { const bf16x8 k00 = *(const LAS bf16x8*)a.kr, k01 = *(const LAS bf16x8*)a.krx, k10 = *(const LAS bf16x8*)(a.kr + 16 * 128), k11 = *(const LAS bf16x8*)(a.krx + 16 * 128);
          const bf16x8 j00 = *(const LAS bf16x8*)(a.kr + BO), j01 = *(const LAS bf16x8*)(a.krx + BO), j10 = *(const LAS bf16x8*)(a.kr + BO + 16 * 128), j11 = *(const LAS bf16x8*)(a.krx + BO + 16 * 128);
          sa0 = MF16(k00, A.q0, sa0); sa1 = MF16(j00, B.q0, sa1); sb0 = MF16(k10, A.q0, sb0); sb1 = MF16(j10, B.q0, sb1);
          sa0 = MF16(k01, A.q1, sa0); sa1 = MF16(j01, B.q1, sa1); sb0 = MF16(k11, A.q1, sb0); sb1 = MF16(j11, B.q1, sb1); }
        bf16x8 va0 = VFR(a.vr0), vb0 = VFR(a.vr0 + BO), va1 = VFR(a.vr1), vb1 = VFR(a.vr1 + BO), va2 = VFR(a.vr2), vb2 = VFR(a.vr2 + BO), va3 = VFR(a.vr3), vb3 = VFR(a.vr3 + BO);
        __builtin_amdgcn_sched_barrier(0);
        bf16x8 pkA, pkB; soft2(A, B, sa0, sb0, sa1, sb1, pkA, pkB);
        asm volatile("" : "+v"(va0), "+v"(vb0), "+v"(va1), "+v"(vb1), "+v"(va2), "+v"(vb2), "+v"(va3), "+v"(vb3));
        A.o0 = MF16(va0, pkA, A.o0); B.o0 = MF16(vb0, pkB, B.o0); A.o1 = MF16(va1, pkA, A.o1); B.o1 = MF16(vb1, pkB, B.o1);
        A.o2 = MF16(va2, pkA, A.o2); B.o2 = MF16(vb2, pkB, B.o2); A.o3 = MF16(va3, pkA, A.o3); B.o3 = MF16(vb3, pkB, B.o3);
    }
    template <int NSTEP>
    static __device__ __forceinline__ void run(const Addr& a, const LAS float* ext_h, const bf16_t* __restrict__ prow, int t0, int lane, unsigned kcol, unsigned vcol, St& A, St& B) {
        const int i16 = lane & 15, fq = lane >> 4, vrow = lane >> 3;
        const int Lb = __builtin_amdgcn_readfirstlane(t0 >> LD), rem = __builtin_amdgcn_readfirstlane(t0 & (D - 1));
        const unsigned offK = (unsigned)(vrow << LD) * ROWB + kcol, offV = (unsigned)(vrow << LD) * ROWB + vcol;
        const LAS float* tb = ext_h + (LD == 4 ? 0 : T2_OFF1) + 15 * QS + 4 * fq - QS * i16;
        Frags fa, fb;
        load(fa, fb, prow, Lb, rem, 0, offK, offV, vrow, kcol, vcol);
#pragma unroll 1
        for (int c = 0; c < NSTEP; ++c) {
            stage(fa, fb, a);
            if (c + 1 < NSTEP) load(fa, fb, prow, Lb, rem, c + 1, offK, offV, vrow, kcol, vcol);
            core(a, tb, Lb, c, fq, A, B);
        }
    }
};
__device__ __forceinline__ void p1_shared(LAS unsigned char* sh, const LAS float* ext_h, const bf16_t* __restrict__ prow, int h, int T, int w, int lane, St& A, St& B) {
    constexpr int NSTEP = 12, VHI = 16 * SH_PITCH;
    const int tid = threadIdx.x, i16 = lane & 15, fq = lane >> 4;
    const int r0 = tid >> 4, c0 = tid & 15; const bool two = tid < 256; const int r1 = 32 + r0;
    const unsigned col0 = (unsigned)((c0 < 8 ? COL_KA : COL_VA - 64) + 64 * h + 8 * c0) * 2u;
    const int d0 = (c0 < 8 ? 0 : SH_TILE) + r0 * SH_PITCH + (c0 & 7) * 16, d1 = d0 + 32 * SH_PITCH;
    auto ld = [&](int c, int row) { int p = T - 64 + 32 * c + row; p = p < 0 ? 0 : (p > SEQ - 1 ? SEQ - 1 : p); return *(const u32x4*)((const char*)prow + (size_t)p * ROWB + col0); };
    u32x4 ga = ld(0, r0), gb = (u32x4){0u, 0u, 0u, 0u}, ha, hb = (u32x4){0u, 0u, 0u, 0u}; if (two) gb = ld(0, r1);
    __syncthreads();
    *(LAS u32x4*)(sh + d0) = ga; if (two) *(LAS u32x4*)(sh + d1) = gb;
    ga = ld(1, r0); if (two) gb = ld(1, r1);
    ha = ld(2, r0); if (two) hb = ld(2, r1);
    const LAS float* tb = ext_h + EXT_OFF2 + 15 * 16 + 4 * fq - 16 * i16;
    const int kro = (w + i16) * SH_PITCH + fq * 16, vro = SH_TILE + (w + 4 * fq + (i16 >> 2)) * SH_PITCH + (i16 & 3) * 8;
    constexpr int BO = 8 * SH_PITCH;
    asm volatile("s_waitcnt lgkmcnt(0)\n\ts_barrier" ::: "memory");
#pragma unroll 1
    for (int c = 0; c < NSTEP; ++c) {
        const LAS unsigned char* bufp = sh + (c & 1) * SH_BUF;
        const int lbase = T + w - 64 + 32 * c;
        const LAS float* t = tb + 32 * c;
        f32x4 sa0 = {t[0], t[1], t[2], t[3]}, sb0 = {t[16], t[17], t[18], t[19]}, sa1 = sa0, sb1 = sb0;
        if (!(lbase >= 0 && lbase + 8 + 31 < SEQ)) { maskrows(sa0, sb0, lbase, fq, SEQ); maskrows(sa1, sb1, lbase + 8, fq, SEQ); }
        { const LAS unsigned char* kp = bufp + kro;
          const bf16x8 k00 = *(const LAS bf16x8*)kp, k01 = *(const LAS bf16x8*)(kp + 64), k10 = *(const LAS bf16x8*)(kp + 16 * SH_PITCH), k11 = *(const LAS bf16x8*)(kp + 16 * SH_PITCH + 64);
          const bf16x8 j00 = *(const LAS bf16x8*)(kp + BO), j01 = *(const LAS bf16x8*)(kp + BO + 64), j10 = *(const LAS bf16x8*)(kp + BO + 16 * SH_PITCH), j11 = *(const LAS bf16x8*)(kp + BO + 16 * SH_PITCH + 64);
          sa0 = MF16(k00, A.q0, sa0); sa1 = MF16(j00, B.q0, sa1); sb0 = MF16(k10, A.q0, sb0); sb1 = MF16(j10, B.q0, sb1);
          sa0 = MF16(k01, A.q1, sa0); sa1 = MF16(j01, B.q1, sa1); sb0 = MF16(k11, A.q1, sb0); sb1 = MF16(j11, B.q1, sb1); }
        bf16x8 pkA, pkB; soft2(A, B, sa0, sb0, sa1, sb1, pkA, pkB);
        { const LAS unsigned char* vp = bufp + vro;
          A.o0 = MF16(VFR(vp), pkA, A.o0); B.o0 = MF16(VFR(vp + BO), pkB, B.o0); A.o1 = MF16(VFR(vp + 32), pkA, A.o1); B.o1 = MF16(VFR(vp + BO + 32), pkB, B.o1);
          A.o2 = MF16(VFR(vp + 64), pkA, A.o2); B.o2 = MF16(VFR(vp + BO + 64), pkB, B.o2); A.o3 = MF16(VFR(vp + 96), pkA, A.o3); B.o3 = MF16(VFR(vp + BO + 96), pkB, B.o3); }
        if (c + 1 < NSTEP) { LAS unsigned char* nb = sh + ((c + 1) & 1) * SH_BUF; *(LAS u32x4*)(nb + d0) = ga; if (two) *(LAS u32x4*)(nb + d1) = gb;
            ga = ha; gb = hb; const int cn = c + 3 < NSTEP ? c + 3 : NSTEP - 1; ha = ld(cn, r0); if (two) hb = ld(cn, r1); }
        asm volatile("s_waitcnt lgkmcnt(0)\n\ts_barrier" ::: "memory");
    }
}
constexpr int XP = 272, X_M = 272 * XP, X_L = X_M + 1088, IMG_ROWS = 400, IMG_V = IMG_ROWS * SH_PITCH;
__device__ __forceinline__ void p1_consec(LAS unsigned char* lds, const LAS float* ext_h, const bf16_t* __restrict__ prow, int h, int T, int w, int lane, St& A, St& B) {
    constexpr int VHI = 16 * SH_PITCH, BO = 16 * SH_PITCH;
    const int tid = fresh_tid(), i16 = tid & 15, fq = (tid & 63) >> 4;
    (void)lane;
    const int c0 = tid & 15, rb = tid >> 4;
    const unsigned col0 = (unsigned)((c0 < 8 ? COL_KA : COL_VA - 64) + 64 * h + 8 * c0) * 2u;
    const int dbase = (c0 < 8 ? 0 : IMG_V) + rb * SH_PITCH + (c0 & 7) * 16;
    auto ld = [&](int k) { int p = T - 64 + rb + 32 * k; p = p < 0 ? 0 : (p > SEQ - 1 ? SEQ - 1 : p); return *(const u32x4*)((const char*)prow + (size_t)p * ROWB + col0); };
    u32x4 g0 = ld(0), g1 = ld(1), g2 = ld(2), g3 = ld(3), g4 = ld(4), g5 = ld(5), g6 = ld(6), g7 = ld(7), g8 = ld(8), g9 = ld(9), g10 = ld(10), g11 = ld(11), g12 = (u32x4){0u, 0u, 0u, 0u};
    if (tid < 256) g12 = ld(12);
    bf16x8 nq0, nq1, nq2, nq3;
    { const bf16_t* qp = prow + (size_t)(T + 32 * w + i16) * NPROJ + COL_QA + 64 * h + 8 * fq;
      nq0 = *(const bf16x8*)qp; nq1 = *(const bf16x8*)(qp + 32); nq2 = *(const bf16x8*)(qp + 16 * NPROJ); nq3 = *(const bf16x8*)(qp + 16 * NPROJ + 32); }
    __syncthreads();
    {
        LAS unsigned char* xa = lds + (w * 17 + i16) * XP + fq * 16; LAS unsigned char* xb = lds + ((w + 8) * 17 + i16) * XP + fq * 16;
        *(LAS f32x4*)(xa) = A.o0; *(LAS f32x4*)(xa + 64) = A.o1; *(LAS f32x4*)(xa + 128) = A.o2; *(LAS f32x4*)(xa + 192) = A.o3;
        *(LAS f32x4*)(xb) = B.o0; *(LAS f32x4*)(xb + 64) = B.o1; *(LAS f32x4*)(xb + 128) = B.o2; *(LAS f32x4*)(xb + 192) = B.o3;
        LAS float* M = (LAS float*)(lds + X_M); LAS float* L = (LAS float*)(lds + X_L);
        const int sa = w * 17 + i16, sb = (w + 8) * 17 + i16;
        if (fq == 0) { M[sa] = A.mref; M[sb] = B.mref; }
        L[sa * 4 + fq] = A.lrun; L[sb * 4 + fq] = B.lrun;
    }
    asm volatile("s_waitcnt lgkmcnt(0)\n\ts_barrier" ::: "memory");
    {
        const int sa = i16 * 17 + 2 * w, sb = sa + 1;
        const LAS unsigned char* xa = lds + sa * XP + fq * 16; const LAS unsigned char* xb = lds + sb * XP + fq * 16;
        A.o0 = *(const LAS f32x4*)(xa); A.o1 = *(const LAS f32x4*)(xa + 64); A.o2 = *(const LAS f32x4*)(xa + 128); A.o3 = *(const LAS f32x4*)(xa + 192);
        B.o0 = *(const LAS f32x4*)(xb); B.o1 = *(const LAS f32x4*)(xb + 64); B.o2 = *(const LAS f32x4*)(xb + 128); B.o3 = *(const LAS f32x4*)(xb + 192);
        const LAS float* M = (const LAS float*)(lds + X_M); const LAS float* L = (const LAS float*)(lds + X_L);
        A.mref = M[sa]; B.mref = M[sb]; A.lrun = L[sa * 4 + fq]; B.lrun = L[sb * 4 + fq];
        A.q0 = nq0; A.q1 = nq1; B.q0 = nq2; B.q1 = nq3;
    }
    asm volatile("s_waitcnt lgkmcnt(0)\n\ts_barrier" ::: "memory");
    *(LAS u32x4*)(lds + dbase) = g0; *(LAS u32x4*)(lds + dbase + 32 * SH_PITCH) = g1; *(LAS u32x4*)(lds + dbase + 64 * SH_PITCH) = g2; *(LAS u32x4*)(lds + dbase + 96 * SH_PITCH) = g3;
    *(LAS u32x4*)(lds + dbase + 128 * SH_PITCH) = g4; *(LAS u32x4*)(lds + dbase + 160 * SH_PITCH) = g5; *(LAS u32x4*)(lds + dbase + 192 * SH_PITCH) = g6;
    *(LAS u32x4*)(lds + dbase + 224 * SH_PITCH) = g7; *(LAS u32x4*)(lds + dbase + 256 * SH_PITCH) = g8; *(LAS u32x4*)(lds + dbase + 288 * SH_PITCH) = g9; *(LAS u32x4*)(lds + dbase + 320 * SH_PITCH) = g10;
    *(LAS u32x4*)(lds + dbase + 352 * SH_PITCH) = g11; if (tid < 256) *(LAS u32x4*)(lds + dbase + 384 * SH_PITCH) = g12;
    asm volatile("s_waitcnt lgkmcnt(0)\n\ts_barrier" ::: "memory");
    const LAS float* tb = ext_h + T2_OFFC + 15 + 4 * fq - i16;
    const int kro = (32 * w + i16) * SH_PITCH + fq * 16, vro = IMG_V + (32 * w + 4 * fq + (i16 >> 2)) * SH_PITCH + (i16 & 3) * 8;
#pragma unroll 1
    for (int c = 0; c < 5; ++c) {
        const int lbase = T + 32 * w - 64 + 32 * c;
        const LAS float* t = tb + 32 * c;
        f32x4 sa0 = {t[0], t[1], t[2], t[3]}, sb0 = {t[16], t[17], t[18], t[19]}, sa1 = sa0, sb1 = sb0;
        if (!(lbase >= 0 && lbase + 16 + 31 < SEQ)) { maskrows(sa0, sb0, lbase, fq, SEQ); maskrows(sa1, sb1, lbase + 16, fq, SEQ); }
        { const LAS unsigned char* kp = lds + kro + 32 * c * SH_PITCH;
          const bf16x8 k00 = *(const LAS bf16x8*)kp, k01 = *(const LAS bf16x8*)(kp + 64), k10 = *(const LAS bf16x8*)(kp + 16 * SH_PITCH), k11 = *(const LAS bf16x8*)(kp + 16 * SH_PITCH + 64);
          const bf16x8 j10 = *(const LAS bf16x8*)(kp + 32 * SH_PITCH), j11 = *(const LAS bf16x8*)(kp + 32 * SH_PITCH + 64);
          sa0 = MF16(k00, A.q0, sa0); sa1 = MF16(k10, B.q0, sa1); sb0 = MF16(k10, A.q0, sb0); sb1 = MF16(j10, B.q0, sb1);
          sa0 = MF16(k01, A.q1, sa0); sa1 = MF16(k11, B.q1, sa1); sb0 = MF16(k11, A.q1, sb0); sb1 = MF16(j11, B.q1, sb1); }
        const LAS unsigned char* vp = lds + vro + 32 * c * SH_PITCH;
        bf16x8 va0 = VFR(vp), vb0 = VFR(vp + BO), va1 = VFR(vp + 32), vb1 = VFR(vp + BO + 32), va2 = VFR(vp + 64), vb2 = VFR(vp + BO + 64), va3 = VFR(vp + 96), vb3 = VFR(vp + BO + 96);
        __builtin_amdgcn_sched_barrier(0);
        bf16x8 pkA, pkB; soft2(A, B, sa0, sb0, sa1, sb1, pkA, pkB);
        asm volatile("" : "+v"(va0), "+v"(vb0), "+v"(va1), "+v"(vb1), "+v"(va2), "+v"(vb2), "+v"(va3), "+v"(vb3));
        A.o0 = MF16(va0, pkA, A.o0); B.o0 = MF16(vb0, pkB, B.o0); A.o1 = MF16(va1, pkA, A.o1); B.o1 = MF16(vb1, pkB, B.o1);
        A.o2 = MF16(va2, pkA, A.o2); B.o2 = MF16(vb2, pkB, B.o2); A.o3 = MF16(va3, pkA, A.o3); B.o3 = MF16(vb3, pkB, B.o3);
    }
    asm volatile("s_waitcnt lgkmcnt(0)\n\ts_barrier" ::: "memory");
}
__device__ __forceinline__ void store_item(const St& s, bf16_t* __restrict__ O, size_t row, int h, int fq) {
    const float l = pg8::fq_sum(s.lrun), inv = 1.f / l;
    bf16_t* op = O + row * DM + 64 * h + 4 * fq;
    u32x2 w; w.x = cvtpk(s.o0[0] * inv, s.o0[1] * inv); w.y = cvtpk(s.o0[2] * inv, s.o0[3] * inv); *(u32x2*)(op) = w;
    w.x = cvtpk(s.o1[0] * inv, s.o1[1] * inv); w.y = cvtpk(s.o1[2] * inv, s.o1[3] * inv); *(u32x2*)(op + 16) = w;
    w.x = cvtpk(s.o2[0] * inv, s.o2[1] * inv); w.y = cvtpk(s.o2[2] * inv, s.o2[3] * inv); *(u32x2*)(op + 32) = w;
    w.x = cvtpk(s.o3[0] * inv, s.o3[1] * inv); w.y = cvtpk(s.o3[2] * inv, s.o3[3] * inv); *(u32x2*)(op + 48) = w;
}
template <int DV>
__device__ __forceinline__ void round(LAS unsigned char* lds, const LAS float* ext_h, int b, int h, int blk, int w, const bf16_t* __restrict__ proj, bf16_t* __restrict__ O, int lane) {
    const int i16 = lane & 15, fq = lane >> 4, vrow = lane >> 3, vch = lane & 7, t0 = 256 * blk + w;
    const bf16_t* prow = proj + (size_t)b * SEQ * NPROJ;
    St A, B;
    { const bf16_t* qp = prow + (size_t)(t0 + 16 * i16) * NPROJ + COL_QA + 64 * h + 8 * fq;
      A.q0 = *(const bf16x8*)qp; A.q1 = *(const bf16x8*)(qp + 32); B.q0 = *(const bf16x8*)(qp + 8 * NPROJ); B.q1 = *(const bf16x8*)(qp + 8 * NPROJ + 32); }
    A.o0 = A.o1 = A.o2 = A.o3 = B.o0 = B.o1 = B.o2 = B.o3 = (f32x4){0.f, 0.f, 0.f, 0.f}; A.mref = B.mref = -1.0e30f; A.lrun = B.lrun = 0.f;
    const unsigned kcol = (unsigned)(COL_KA + 64 * h + 8 * vch) * 2u, vcol = (unsigned)(COL_VA + 64 * h + 8 * vch) * 2u;
    LAS unsigned char* vst = lds + w * WTILE; LAS unsigned char* ktile = vst + 4096;
    Addr a;
    a.kw = ktile + vrow * 128 + ((vch ^ ((vrow >> 1) & 7)) * 16); a.kwx = ktile + vrow * 128 + ((vch ^ ((vrow >> 1) & 7) ^ 4) * 16);
    a.kr = ktile + i16 * 128 + ((fq ^ ((i16 >> 1) & 7)) * 16); a.krx = ktile + i16 * 128 + (((fq + 4) ^ ((i16 >> 1) & 7)) * 16);
    a.vw = vst + (vch >> 1) * 1024 + ((vrow ^ (vch >> 1)) * 32) + (vch & 1) * 16;
    a.vr0 = vst + 0 * 1024 + (4 * fq + ((i16 >> 2) ^ 0)) * 32 + (i16 & 3) * 8; a.vr1 = vst + 1 * 1024 + (4 * fq + ((i16 >> 2) ^ 1)) * 32 + (i16 & 3) * 8;
    a.vr2 = vst + 2 * 1024 + (4 * fq + ((i16 >> 2) ^ 2)) * 32 + (i16 & 3) * 8; a.vr3 = vst + 3 * 1024 + (4 * fq + ((i16 >> 2) ^ 3)) * 32 + (i16 & 3) * 8;
    if (DV != 2) { Pat2<4>::run<5>(a, ext_h, prow, t0, lane, kcol, vcol, A, B);
    Pat2<2>::run<6>(a, ext_h, prow, t0, lane, kcol, vcol, A, B); }
    if (DV != 1) p1_consec(lds, ext_h, prow, h, 256 * blk, w, lane, A, B);
    store_item(A, O, (size_t)b * SEQ + 256 * blk + 32 * w + i16, h, fq);
    store_item(B, O, (size_t)b * SEQ + 256 * blk + 32 * w + 16 + i16, h, fq);
}
#undef MF16
#undef VFR
}

__device__ __forceinline__ int rowmap(int n, int mode) {
    if (mode == 1) { if (n >= COL_KR) { const int c = n - COL_KR; return COL_KR + (c < 16 ? 2 * c : 2 * (c - 16) + 1); } return n; }
    if (mode == 2) { const int h = n / 96, w = n % 96; if (w >= 64) { const int c = w - 64; return 96 * h + 64 + (c < 16 ? 2 * c : 2 * (c - 16) + 1); } return n; }
    return n;
}
__device__ __forceinline__ void p0_transpose_item(const float* __restrict__ W, const float* __restrict__ g, int K, int N, bf16_t* __restrict__ WT, int mode, LAS float* scr, int item, int lane) {
    const int nblk = N / 32, kb = item / nblk, nb = item % nblk, k0 = 64 * kb, n0 = 32 * nb;
#pragma unroll
    for (int i = 0; i < 32; ++i) { const int kk = 2 * i + (lane >> 5); const float gv = g ? g[k0 + kk] : 1.f; scr[kk * 33 + (lane & 31)] = W[(size_t)(k0 + kk) * N + n0 + (lane & 31)] * gv; }
    asm volatile("s_waitcnt lgkmcnt(0)" ::: "memory");
    const int c = lane & 7;
#pragma unroll
    for (int j = 0; j < 4; ++j) { const int n = (lane >> 3) + 8 * j; const LAS float* s = scr + (8 * c) * 33 + n;
        u32x4 o; o.x = cvtpk(s[0 * 33], s[1 * 33]); o.y = cvtpk(s[2 * 33], s[3 * 33]); o.z = cvtpk(s[4 * 33], s[5 * 33]); o.w = cvtpk(s[6 * 33], s[7 * 33]);
        *(u32x4*)(WT + (size_t)rowmap(n0 + n, mode) * K + k0 + 8 * c) = o; }
    asm volatile("s_waitcnt lgkmcnt(0)" ::: "memory");
}

__device__ __forceinline__ void grid_barrier(unsigned* bar, unsigned G, unsigned& epoch) {
    asm volatile("s_waitcnt vmcnt(0)" ::: "memory");
    __syncthreads();
    if (threadIdx.x == 0) {
        __builtin_amdgcn_fence(__ATOMIC_RELEASE, "agent");
        asm volatile("s_waitcnt vmcnt(0)" ::: "memory");
        const unsigned target = (epoch + 1u) * G;
        __hip_atomic_fetch_add(bar, 1u, __ATOMIC_RELAXED, __HIP_MEMORY_SCOPE_AGENT);
        unsigned spins = 0;
        while (__hip_atomic_load(bar, __ATOMIC_RELAXED, __HIP_MEMORY_SCOPE_AGENT) < target) { __builtin_amdgcn_s_sleep(2); if (++spins > (1u << 24)) break; }
        __builtin_amdgcn_fence(__ATOMIC_ACQUIRE, "agent");
        asm volatile("s_waitcnt vmcnt(0)" ::: "memory");
    }
    ++epoch;
    __syncthreads();
}

#define XB_TMO      128
#define XB_XCNT(j)  (256  + 64 * (j))
#define XB_XSUB(j)  (1280 + 64 * (j))
#define XB_XGEN(j)  (2304 + 64 * (j))
#define XB_TOP      3328
#define XB_TOPGEN   3392
#define XCD_BAR_WORDS 3456
#define XB_SPIN_CAP (1u << 18)
__device__ __forceinline__ unsigned xb_ld(unsigned* p)              { return __hip_atomic_load(p, __ATOMIC_RELAXED, __HIP_MEMORY_SCOPE_AGENT); }
__device__ __forceinline__ unsigned xb_add(unsigned* p, unsigned v) { return __hip_atomic_fetch_add(p, v, __ATOMIC_RELAXED, __HIP_MEMORY_SCOPE_AGENT); }
__device__ __forceinline__ unsigned xb_xcc_id() { return (unsigned)__builtin_amdgcn_s_getreg((3 << 11) | 20) & 0xFu; }
#define XB_SPIN(cond, bar) do { unsigned _sp = 0; while (cond) { __builtin_amdgcn_s_sleep(1); \
    if ((++_sp & 255u) == 0u) { if (xb_ld(&(bar)[XB_TMO])) break; if (_sp > XB_SPIN_CAP) { atomicAdd(&(bar)[XB_TMO], 1u); break; } } } } while (0)
struct XcdBarrier { unsigned* bar; unsigned x; volatile LAS unsigned* st; };
__device__ __forceinline__ XcdBarrier xcd_barrier_post(unsigned* bar, volatile LAS unsigned* st) {
    XcdBarrier b; b.bar = bar; b.x = xb_xcc_id(); b.st = st;
    if (threadIdx.x == 0) (void)xb_add(&bar[XB_XCNT(b.x)], 1u);
    return b;
}
__device__ __forceinline__ void xcd_barrier_complete(unsigned* bar, unsigned x, unsigned& nloc, unsigned& nx) {
    const unsigned G = gridDim.x;
    unsigned sum, cnt, mine, sp = 0u;
    for (;;) {
        sum = 0u; cnt = 0u; mine = 0u;
#pragma unroll
        for (unsigned j = 0; j < 16; ++j) { const unsigned c = xb_ld(&bar[XB_XCNT(j)]); sum += c; cnt += (c > 0u) ? 1u : 0u; mine = (j == x) ? c : mine; }
        if (sum == G) break;
        __builtin_amdgcn_s_sleep(1);
        if ((++sp & 255u) == 0u) { if (xb_ld(&bar[XB_TMO])) break; if (sp > XB_SPIN_CAP) { atomicAdd(&bar[XB_TMO], 1u); break; } }
    }
    nloc = mine > 0u ? mine : 1u; nx = cnt > 0u ? cnt : 1u;
}
__device__ __forceinline__ void xcd_barrier(const XcdBarrier& b) {
    asm volatile("s_waitcnt vmcnt(0)" ::: "memory");
    __syncthreads();
    if (threadIdx.x == 0) {
        unsigned* bar = b.bar;
        __builtin_amdgcn_s_waitcnt(0);
        unsigned nloc = b.st[0], nx = b.st[1];
        if (nloc == 0u) { xcd_barrier_complete(bar, b.x, nloc, nx); b.st[0] = nloc; b.st[1] = nx; }
        const unsigned old = xb_add(&bar[XB_XSUB(b.x)], 1u);
        const unsigned gen = old / nloc;
        if (old + 1u == (gen + 1u) * nloc) {
            __builtin_amdgcn_fence(__ATOMIC_RELEASE, "agent");
            asm volatile("s_waitcnt vmcnt(0)" ::: "memory");
            const unsigned og = xb_add(&bar[XB_TOP], 1u);
            const unsigned tg = og / nx;
            if (og + 1u == (tg + 1u) * nx) xb_add(&bar[XB_TOPGEN], 1u);
            else XB_SPIN(xb_ld(&bar[XB_TOPGEN]) == tg, bar);
            __builtin_amdgcn_fence(__ATOMIC_ACQUIRE, "agent");
            xb_add(&bar[XB_XGEN(b.x)], 1u);
            asm volatile("s_waitcnt vmcnt(0)" ::: "memory");
        } else {
            XB_SPIN(xb_ld(&bar[XB_XGEN(b.x)]) == gen, bar);
            __builtin_amdgcn_fence(__ATOMIC_ACQUIRE, "agent");
            asm volatile("s_waitcnt vmcnt(0)" ::: "memory");
        }
    }
    __syncthreads();
}

__device__ __forceinline__ void transpose_item64(const float* __restrict__ W, const float* __restrict__ g, int K, int N, bf16_t* __restrict__ WT, int MODE, LAS unsigned* scr, int item, int lane) {
    const int nblk = (N + 63) / 64, kb = item / nblk, nb = item % nblk, k0 = 64 * kb, n0 = 64 * nb;
    const int nq = lane & 15, kq = lane >> 4;
    f32x4 a[8], b[8];
#pragma unroll
    for (int j = 0; j < 8; ++j) { const int nn = (n0 + 4 * nq < N) ? n0 + 4 * nq : N - 4;
        const float* p = W + (size_t)(k0 + 2 * (4 * j + kq)) * N + nn; a[j] = __builtin_nontemporal_load((const f32x4*)p); b[j] = __builtin_nontemporal_load((const f32x4*)(p + N)); }
#pragma unroll
    for (int j = 0; j < 8; ++j) { const int kp = 4 * j + kq; float g0 = 1.f, g1 = 1.f; if (g) { g0 = g[k0 + 2 * kp]; g1 = g[k0 + 2 * kp + 1]; }
#pragma unroll
        for (int i = 0; i < 4; ++i) scr[(4 * nq + i) * 33 + kp] = cvtpk(a[j][i] * g0, b[j][i] * g1); }
    asm volatile("s_waitcnt lgkmcnt(0)" ::: "memory");
    const int c = lane & 7;
#pragma unroll
    for (int j = 0; j < 8; ++j) { const int n = (lane >> 3) + 8 * j; const LAS unsigned* sp = scr + n * 33 + 4 * c;
        u32x4 o; o.x = sp[0]; o.y = sp[1]; o.z = sp[2]; o.w = sp[3];
        if (n0 + n < N) *(u32x4*)(WT + (size_t)rowmap(n0 + n, MODE) * K + k0 + 8 * c) = o; }
    asm volatile("s_waitcnt lgkmcnt(0)" ::: "memory");
}

struct Args { const float* in[13]; float* out; unsigned char* ws; int ph_lo, ph_hi; int flags; int pad; };

__global__ void __launch_bounds__(NTHREADS, 2) mega(Args args) {
    extern __shared__ __attribute__((aligned(16))) unsigned char lds_raw[];
    LAS unsigned char* lds = (LAS unsigned char*)lds_raw;
    const int wid = __builtin_amdgcn_readfirstlane((int)threadIdx.x >> 6);
    const int G = gridDim.x, bx = blockIdx.x;
    const int vcu = (G % 8 == 0) ? (bx % 8) * (G / 8) + bx / 8 : bx;
    const int gw = vcu * NWAVES + wid, NGW = G * NWAVES;
    unsigned char* ws = args.ws;
    const float* x = args.in[0]; float* out = args.out;
    float* ssq_q = (float*)(ws + WS_SSQ_Q); float* ssq_kv = (float*)(ws + WS_SSQ_KV); float* ssq_h1 = (float*)(ws + WS_SSQ_H1); float* ssq_h2 = (float*)(ws + WS_SSQ_H2);
    float2* rope = (float2*)(ws + WS_ROPE); float* xrs = (float*)(ws + WS_XRS);
    bf16_t* Wt_in = (bf16_t*)(ws + WS_WIN); bf16_t* Wt_qb = (bf16_t*)(ws + WS_WQB); bf16_t* Wt_kvb = (bf16_t*)(ws + WS_WKVB);
    bf16_t* Wt_out = (bf16_t*)(ws + WS_WOUT); bf16_t* Wt_up = (bf16_t*)(ws + WS_WUP); bf16_t* Wt_down = (bf16_t*)(ws + WS_WDOWN);
    bf16_t* xn = (bf16_t*)(ws + WS_XN); bf16_t* o = (bf16_t*)(ws + WS_O); bf16_t* proj = (bf16_t*)(ws + WS_PROJ);
    bf16_t* qb = (bf16_t*)(ws + WS_QB); bf16_t* kvb = (bf16_t*)(ws + WS_KVB); bf16_t* kpe = (bf16_t*)(ws + WS_KPE);
    bf16_t* h1b = (bf16_t*)(ws + WS_H1B); bf16_t* act = (bf16_t*)(ws + WS_ACT);
    const int lo = args.ph_lo, hi = args.ph_hi;
#define IN(k) (lo <= (k) && (k) < hi)
    volatile LAS unsigned* bst = (volatile LAS unsigned*)(lds + LDS_BYTES - 64);
    XcdBarrier xbar; xbar.bar = (unsigned*)(ws + WS_CTL + 512 * 1024); xbar.x = 0; xbar.st = bst;
    if (hi - lo > 1) {
        { u32x4* z = (u32x4*)(ws + WS_CTL); for (int i = bx * NTHREADS + (int)threadIdx.x; i < (int)(CTL_BYTES / 16); i += G * NTHREADS) if (i < 32768 || i >= 33792) z[i] = (u32x4){0u, 0u, 0u, 0u}; }
        if (args.flags < 0) cg::this_grid().sync();
        if (threadIdx.x < 2) bst[threadIdx.x] = 0u;
        __syncthreads();
        xbar = xcd_barrier_post((unsigned*)(ws + WS_CTL + 512 * 1024), bst);
    }
#define SEAM(k) do { if (IN(k) && IN((k) + 1)) xcd_barrier(xbar); } while (0)

    if (IN(0)) {
        const int tid = fresh_tid(), lane = tid & 63;
        LAS float* scr = (LAS float*)(lds + wid * 16384);
        constexpr int I_IN = (DM / 64) * ((NPROJ_REAL + 63) / 64), I_QB = (256 / 64) * (NQB / 64), I_KVB = (128 / 64) * (NKVB / 64);
        constexpr int NITEMS = I_IN + I_QB + I_KVB;
#pragma unroll 1
        for (int it = gw; it < NITEMS; it += NGW) {
            int r = it; const float* W = args.in[2]; const float* gn = args.in[1]; int K = DM, N = NPROJ_REAL, mode = 1; bf16_t* WT = Wt_in;
            if (r >= I_IN) { r -= I_IN; W = args.in[4]; gn = args.in[3]; K = 256; N = NQB; mode = 2; WT = Wt_qb;
                if (r >= I_QB) { r -= I_QB; W = args.in[6]; gn = args.in[5]; K = 128; N = NKVB; mode = 0; WT = Wt_kvb; } }
            transpose_item64(W, gn, K, N, WT, mode, (LAS unsigned*)scr, r, lane);
        }
        { u32x4* z = (u32x4*)(Wt_in + (size_t)NPROJ_REAL * DM); const int nz = (NPROJ - NPROJ_REAL) * DM * 2 / 16;
          for (int i = bx * NTHREADS + tid; i < nz; i += G * NTHREADS) z[i] = (u32x4){0u, 0u, 0u, 0u}; }
        for (int idx = bx * NTHREADS + tid; idx < SEQ * 16; idx += G * NTHREADS) { const int t = idx >> 4, j = idx & 15;
            const float invf = powf(10000.0f, -(float)(2 * j) / 32.0f); const float ang = (float)t * invf; float s, c; sincosf(ang, &s, &c); rope[idx] = make_float2(c, s); }
        for (int m = gw; m < MTOK; m += 4 * NGW) {
            f32x4 v[4][4];
#pragma unroll
            for (int q = 0; q < 4; ++q) { const f32x4* xr = (const f32x4*)(x + (size_t)(m + q * NGW) * DM) + lane;
#pragma unroll
                for (int j = 0; j < 4; ++j) v[q][j] = __builtin_nontemporal_load(xr + 64 * j); }
#pragma unroll
            for (int q = 0; q < 4; ++q) { float s = 0.f;
#pragma unroll
                for (int j = 0; j < 4; ++j) s += pg8::sq4(v[q][j]);
                const float ms = wave_sum(s) * (1.f / DM) + EPS; const float rstd = rsqrtf(ms);
                if (lane == 0) xrs[m + q * NGW] = sqrtf(ms);
                u32x2* op = (u32x2*)(xn + (size_t)(m + q * NGW) * DM) + lane;
#pragma unroll
                for (int j = 0; j < 4; ++j) { u32x2 w; w.x = cvtpk(v[q][j][0] * rstd, v[q][j][1] * rstd); w.y = cvtpk(v[q][j][2] * rstd, v[q][j][3] * rstd); op[64 * j] = w; } }
        }
        __syncthreads();
    }
    SEAM(0);
    if (IN(1)) {
        pg8::Gemm g{xn, Wt_in, DM, DM, DM}; pg8::StaticOrder S; S.init(MTOK, NPROJ, G, bx);
        pg8::EpiProj E{proj, ssq_q, ssq_kv, kpe, rope};
        pg8::gemm_phase(lds, g, S, E);
    }
    SEAM(1);
    if (IN(2)) {
        if (G == 256) {
            const int panel = (bx & 7) + 8 * (bx >> 4);
            if (((bx >> 3) & 1) == 0) { pg8::Gemm g{proj + COL_CQ, Wt_qb, NPROJ, 256, 256}; pg8::PanelOrder S{panel, NQB / 256}; pg8::EpiQ E{qb, ssq_q, rope}; pg8::gemm_phase(lds, g, S, E); }
            else { pg8::Gemm g{proj + COL_CKV, Wt_kvb, NPROJ, 128, 128}; pg8::PanelOrder S{panel, NKVB / 256}; pg8::EpiKV E{kvb, ssq_kv}; pg8::gemm_phase(lds, g, S, E); }
        } else {
        { pg8::Gemm g{proj + COL_CQ, Wt_qb, NPROJ, 256, 256}; pg8::StaticOrder S; S.init(MTOK, NQB, G, bx); pg8::EpiQ E{qb, ssq_q, rope}; pg8::gemm_phase(lds, g, S, E); }
        { pg8::Gemm g{proj + COL_CKV, Wt_kvb, NPROJ, 128, 128}; pg8::StaticOrder S; S.init(MTOK, NKVB, G, (bx + G / 2) % G); pg8::EpiKV E{kvb, ssq_kv}; pg8::gemm_phase(lds, g, S, E); }
        }
    }
    SEAM(2);
    if (IN(3)) {
        if (!(args.flags & 2)) {
#ifdef MLA_VARIANT
#define MLA_CALL do { if (args.flags & 16) mla::unit<MLA_VARIANT>(lds, bh >> 3, bh & 7, qblk, qb, kvb, kpe, o); else mla::unit<0>(lds, bh >> 3, bh & 7, qblk, qb, kvb, kpe, o); } while (0)
#else
#define MLA_CALL mla::unit<0>(lds, bh >> 3, bh & 7, qblk, qb, kvb, kpe, o)
#endif
            if (G == 256) { const int xcd = vcu >> 5, slot = vcu & 31;
                for (int i = 0; i < 4; ++i) { const int bh = xcd * 8 + i * 2 + (slot >> 4), qblk = slot & 15; MLA_CALL; } }
            else for (int u = vcu; u < BATCH * 8 * 16; u += G) { const int bh = u >> 4, qblk = u & 15; MLA_CALL; }
        }
        if (!(args.flags & 1)) {
            const int lane = fresh_tid() & 63;
            __syncthreads();
            if (G == 256) { const int b = vcu >> 5, slot = vcu & 31;
#ifdef DIL_VARIANT
                if (args.flags & 32) {
                    if (DIL_VARIANT == 11) { for (int i = 0; i < 4096; ++i) asm volatile("s_barrier" ::: "memory"); }
                    else if (DIL_VARIANT == 12) { float x = (float)lane; for (int i = 0; i < 4096; ++i) {
#pragma unroll
                        for (int j = 0; j < 64; ++j) x = __builtin_fmaf(x, 1.0000001f, 0.5f); asm volatile("" : "+v"(x)); }
                        if (x == 12345.f) o[0] = 1; }
                    else if (DIL_VARIANT == 13) { u32x4 v = (u32x4){(unsigned)lane, 1u, 2u, 3u}; LAS u32x4* p = (LAS u32x4*)(lds + wid * 4096 + lane * 16); LAS u32x4* q = (LAS u32x4*)(lds + ((wid + 1) & 7) * 4096 + lane * 16);
                        for (int i = 0; i < 4096; ++i) { *p = v; asm volatile("s_waitcnt lgkmcnt(0)\n\ts_barrier" ::: "memory"); v = *q; asm volatile("s_waitcnt lgkmcnt(0)\n\ts_barrier" ::: "memory"); }
                        if (v.x == 0x12345678u) o[0] = 1; }
                } else
#endif
                { LAS float* ext4 = (LAS float*)(lds + 131072); dil2::build_ext_all(ext4, args.in[11], slot & 1); __syncthreads();
                  for (int i = 0; i < 4; ++i) dil2::round<0>(lds, ext4 + i * dil2::T2_H, b, 2 * i + (slot & 1), slot >> 1, wid, proj, o, lane); } }
            else {
                LAS float* ext = (LAS float*)(lds + 65536);
                dil::build_ext(ext, args.in[11]);
                __syncthreads();
                LAS unsigned char* vst = lds + wid * 8192;
                for (int it = gw * 8; it < BATCH * 8 * 16 * 16; it += NGW * 8)
                    for (int k = 0; k < 8; ++k) { const int id = it + k; const int r = id & 15, blk = (id >> 4) & 15, h = (id >> 8) & 7, b = id >> 11; dil::item<false, 0>(vst, ext, lds + 102400, 0, b, h, blk, r, proj, o, lane); }
            }
            __syncthreads();
        }
        { const int lane = fresh_tid() & 63;
          unsigned* qctr = (unsigned*)(ws + WS_CTL + 700 * 1024);
          constexpr int L_OUT = (DM / 64) * (DM / 64), L_UP = (DM / 64) * (DFF / 64), L_DN = (DFF / 64) * (DM / 64);
          LAS unsigned* scr2 = (LAS unsigned*)(lds + wid * 16384);
          LAS unsigned* qs = (LAS unsigned*)(lds + 131072);
          for (;;) {
              __syncthreads();
              if (threadIdx.x == 0) qs[0] = __hip_atomic_fetch_add(qctr, 1u, __ATOMIC_RELAXED, __HIP_MEMORY_SCOPE_AGENT);
              __syncthreads();
              const int chunk = __builtin_amdgcn_readfirstlane((int)qs[0]);
              if (chunk * 16 >= L_OUT + L_UP + L_DN) break;
#pragma unroll 1
              for (int k = 0; k < 2; ++k) { int r = chunk * 16 + wid * 2 + k;
                  if (r < L_OUT) { transpose_item64(args.in[7], nullptr, DM, DM, Wt_out, 0, scr2, r, lane); continue; } r -= L_OUT;
                  if (r < L_UP) { transpose_item64(args.in[9], args.in[8], DM, DFF, Wt_up, 0, scr2, r, lane); continue; } r -= L_UP;
                  transpose_item64(args.in[10], nullptr, DFF, DM, Wt_down, 0, scr2, r, lane); }
          }
          __syncthreads(); }
    }
    SEAM(3);
    if (IN(4)) {
        pg8::Gemm g{o, Wt_out, DM, DM, DM}; pg8::StaticOrder S; S.init(MTOK, DM, G, bx);
        pg8::EpiOut E{xn, xrs, h1b, ssq_h1};
        pg8::gemm_phase(lds, g, S, E);
    }
    SEAM(4);
    if (IN(5)) {
        pg8::Gemm g{h1b, Wt_up, DM, DM, DM}; pg8::StaticOrder S; S.init(MTOK, DFF, G, bx);
        pg8::EpiUp E{act, ssq_h1};
        pg8::gemm_phase(lds, g, S, E);
    }
    SEAM(5);
    const bool fuse_final = (G == 256);
    if (IN(6)) {
        pg8::Gemm g{act, Wt_down, DFF, DFF, DFF}; pg8::StaticOrder S; S.init(MTOK, DM, G, bx);
        if (fuse_final) { pg8::EpiDownFused E{h1b, out, args.in[12], (float*)(ws + WS_XBUF), (unsigned*)(ws + WS_CTL + 576 * 1024), lds + pg8::STAGE_BYTES}; pg8::gemm_phase(lds, g, S, E); }
        else { pg8::EpiDown E{h1b, out, ssq_h2}; pg8::gemm_phase(lds, g, S, E); }
    }
    if (!fuse_final) {
    SEAM(6);
    if (IN(7)) {
        const int lane = fresh_tid() & 63;
        const f32x4* gr = (const f32x4*)args.in[12] + lane; f32x4 gg[4];
#pragma unroll
        for (int j = 0; j < 4; ++j) gg[j] = gr[64 * j];
        for (int m = gw; m < MTOK; m += NGW) {
            const float r = rsqrtf(ssq_h2[m] * (1.f / DM) + EPS);
            f32x4* xr = (f32x4*)(out + (size_t)m * DM) + lane;
#pragma unroll
            for (int j = 0; j < 4; ++j) xr[64 * j] = xr[64 * j] * gg[j] * r;
        }
    }
    }
#undef IN
#undef SEAM
}

extern "C" void kernel_launch(void* const* d_in, const int* in_sizes, int n_in, void* d_out, int out_size, void* d_ws, size_t ws_size, hipStream_t stream) {
    if (ws_size < WS_END || n_in < 13) { fprintf(stderr, "kernel_launch: workspace too small (%zu) or inputs missing (%d)\n", ws_size, n_in); return; }
    static int grid = 0;
    if (grid == 0) {
        int dev = 0, cus = 0, per_cu = 0;
        (void)hipGetDevice(&dev); (void)hipDeviceGetAttribute(&cus, hipDeviceAttributeMultiprocessorCount, dev);
        if (hipFuncSetAttribute((const void*)mega, hipFuncAttributeMaxDynamicSharedMemorySize, LDS_BYTES) != hipSuccess) { fprintf(stderr, "kernel_launch: hipFuncSetAttribute failed\n"); grid = -1; return; }
        if (hipOccupancyMaxActiveBlocksPerMultiprocessor(&per_cu, (const void*)mega, NTHREADS, LDS_BYTES) != hipSuccess || per_cu < 1) { fprintf(stderr, "kernel_launch: occupancy query failed (%d)\n", per_cu); per_cu = 1; }
        (void)hipGetLastError();
        grid = cus;
        if (grid <= 0) grid = 256;
    }
    if (grid < 0) return;
    unsigned char* ws = (unsigned char*)d_ws; float* out = (float*)d_out;
    (void)hipMemsetAsync(ws + WS_CTL + 512 * 1024, 0, 16 * 1024, stream);
    Args a{};
    for (int i = 0; i < 13; ++i) a.in[i] = (const float*)d_in[i];
    a.out = out; a.ws = ws;
    a.ph_lo = 0; a.ph_hi = 8; a.flags = 0;
    void* kargs[] = {&a};
    hipError_t e = hipLaunchCooperativeKernel((const void*)mega, dim3(grid), dim3(NTHREADS), kargs, LDS_BYTES, stream);
    if (e != hipSuccess) fprintf(stderr, "kernel_launch: cooperative launch failed: %s (grid %d)\n", hipGetErrorString(e), grid);
}
```

```cpp
#include <hip/hip_runtime.h>
#include <cstdint>
#include <cstdio>

typedef unsigned short bf16_t;

constexpr int BATCH = 8, SEQ = 4096, DM = 1024, MTOK = BATCH * SEQ;
constexpr int NPROJ = 2048;
constexpr int PPITCH = NPROJ;
constexpr int NPROJ_REAL = 1952;
constexpr int COL_QA = 0, COL_KA = 512, COL_VA = 1024, COL_CQ = 1536, COL_CKV = 1792, COL_KR = 1920;
constexpr int NQB = 768, NKVB = 1024, DFF = 4096;
constexpr float EPS = 1e-6f;
constexpr float LOG2E = 1.4426950408889634f;
constexpr float QSCALE_A = 0.125f * LOG2E;
constexpr float QSCALE_B = 0.10206207261596575f * LOG2E;

constexpr size_t MiB = 1u << 20;
constexpr size_t WS_CTL = 0, CTL_BYTES = 1 * MiB;
constexpr size_t WS_SSQ_Q = 0, WS_SSQ_KV = 128 * 1024, WS_SSQ_H1 = 256 * 1024, WS_SSQ_H2 = 384 * 1024;
constexpr size_t WS_ROPE = 1 * MiB;
constexpr size_t WS_XBUF = 1 * MiB + 512 * 1024;
constexpr size_t WS_WIN = 2 * MiB, WS_WQB = 6 * MiB, WS_WKVB = 7 * MiB, WS_WOUT = 8 * MiB, WS_WUP = 10 * MiB, WS_WDOWN = 18 * MiB;
constexpr size_t WS_XN = 32 * MiB, WS_O = 404 * MiB, WS_XRS = 468 * MiB;
constexpr size_t WS_PROJ = 96 * MiB, WS_QB = 224 * MiB, WS_KVB = 272 * MiB, WS_KPE = 336 * MiB, WS_H1B = 340 * MiB;
constexpr size_t WS_ACT = 32 * MiB;
constexpr size_t WS_END = 469 * MiB;

__device__ __forceinline__ unsigned f2bf(float f) { unsigned u = __builtin_bit_cast(unsigned, f); return (u + 0x7fffu + ((u >> 16) & 1u)) >> 16; }
__device__ __forceinline__ float bf2f(bf16_t h) { return __builtin_bit_cast(float, (unsigned)h << 16); }
__device__ __forceinline__ float wave_sum(float v) {
#pragma unroll
    for (int o = 1; o < 64; o <<= 1) v += __shfl_xor(v, o);
    return v;
}
__device__ __forceinline__ float wave_max(float v) {
#pragma unroll
    for (int o = 1; o < 64; o <<= 1) v = fmaxf(v, __shfl_xor(v, o));
    return v;
}
__device__ __forceinline__ int t5_bucket(int rel) {
    const int n = rel < 0 ? -rel : rel;
    int b;
    if (n < 8) b = n;
    else b = 8 + (n >= 15) + (n >= 27) + (n >= 50) + (n >= 91) + (n >= 166) + (n >= 305) + (n >= 559);
    return b + (rel > 0 ? 16 : 0);
}


#include <hip/hip_cooperative_groups.h>
namespace cg = cooperative_groups;
#define LAS __attribute__((address_space(3)))
typedef short bf16x8 __attribute__((ext_vector_type(8)));
typedef short s16x4 __attribute__((ext_vector_type(4)));
typedef float f32x4 __attribute__((ext_vector_type(4)));
typedef float f32x16 __attribute__((ext_vector_type(16)));
typedef unsigned u32x4 __attribute__((ext_vector_type(4)));
typedef unsigned u32x2 __attribute__((ext_vector_type(2)));
typedef float f32x2_t __attribute__((ext_vector_type(2)));
typedef __bf16 bf16x2_t __attribute__((ext_vector_type(2)));
__device__ __forceinline__ unsigned cvtpk(float lo, float hi) { f32x2_t v = {lo, hi}; bf16x2_t b = __builtin_convertvector(v, bf16x2_t); return __builtin_bit_cast(unsigned, b); }
__device__ __forceinline__ s16x4 tr16(const LAS unsigned char* p) { typedef short v4i16_t __attribute__((ext_vector_type(4))); return __builtin_bit_cast(s16x4, __builtin_amdgcn_ds_read_tr16_b64_v4i16((LAS v4i16_t*)p)); }

constexpr int NWAVES = 8, NTHREADS = 512;
__device__ __forceinline__ int fresh_tid() { int t = threadIdx.x; asm volatile("" : "+v"(t)); return t; }
constexpr int LDS_BYTES = 147456;

namespace pg8 {
constexpr int BM = 256, BK = 64, HALF = 128, HTB = HALF * BK * 2, STAGE_BYTES = 8 * HTB, NXCD = 8, WGM = 8;
__host__ __device__ __forceinline__ int lds_byte(int r, int c) { const int st = (r >> 4) * 2 + (c >> 5), rr = r & 15, cc = c & 31, ob = rr * 64 + cc * 2; return st * 1024 + (ob ^ (((ob >> 9) & 1) << 5)); }
__host__ __device__ __forceinline__ void stage_rc(int b, int& R, int& C) { const int st = b / 1024, sb = b % 1024, swz = sb ^ (((sb >> 9) & 1) << 5); R = (st >> 1) * 16 + swz / 64; C = (st & 1) * 32 + (swz % 64) / 2; }
__host__ __device__ __forceinline__ int perm32(int rho) { const int n = rho >> 4, i = rho & 15; return 8 * (i >> 2) + 4 * n + (i & 3); }
struct Unit { int pm, pn; };
struct Gemm { const bf16_t* A; const bf16_t* Bt; int lda, ldb, K; };
struct StaticOrder {
    int nM, nN, nwg, G, c;
    __device__ void init(int M, int N, int G_, int c_) { nM = M / BM; nN = N / BM; nwg = nM * nN; G = G_; c = c_; }
    __device__ bool next(int i, Unit& u) const {
        const long L = (long)i * G + c; if (L >= nwg) return false;
        int wgid = (int)L; { const int q = nwg / NXCD, r = nwg % NXCD, xcd = wgid % NXCD, off = wgid / NXCD; wgid = (xcd < r ? xcd * (q + 1) : r * (q + 1) + (xcd - r) * q) + off; }
        const int nig = WGM * nN, gid = wgid / nig, fm = gid * WGM, gsz = (nM - fm) < WGM ? (nM - fm) : WGM;
        u.pm = fm + ((wgid % nig) % gsz); u.pn = (wgid % nig) / gsz; return true;
    }
};
template <class Epi>
__device__ __forceinline__ void gemm_phase(LAS unsigned char* lds, const Gemm g, const StaticOrder& S, const Epi& E) {
    const int tid = fresh_tid(), wid = __builtin_amdgcn_readfirstlane(tid >> 6), lane = tid & 63, wr = wid >> 2, wc = wid & 3, fr = lane & 15, fq = lane >> 4;
    const int K = g.K, nt = K / BK;
    unsigned voffA[2], voffB[2];
#pragma unroll
    for (int i = 0; i < 2; ++i) { int R, C; stage_rc(tid * 16 + i * 8192, R, C); const int Rb = (R & ~31) + perm32(R & 31);
        voffA[i] = (unsigned)(R * g.lda + C) * 2u; voffB[i] = (unsigned)(Rb * g.ldb + C) * 2u; }
    const size_t kstep = (size_t)(BK * 2);
    const size_t hstepA = (size_t)HALF * g.lda * 2, hstepB = (size_t)HALF * g.ldb * 2;
    const size_t tstepA = 2 * hstepA, tstepB = 2 * hstepB;
    const unsigned ldsw = (unsigned)wid * 1024u;
    const int aoff = lds_byte(wr * 64 + fr, fq * 8), boff = lds_byte(wc * 32 + fr, fq * 8);
#define PG8_SA(b, h) (((b) * 2 + (h)) * HTB)
#define PG8_SB(b, h) ((4 + (b) * 2 + (h)) * HTB)
#define PG8_STAGE(bufoff, gbase, voff) do { _Pragma("unroll") for (int _i = 0; _i < 2; ++_i) \
        __builtin_amdgcn_global_load_lds((const unsigned*)((const char*)(gbase) + (voff)[_i]), (LAS unsigned*)(lds + (bufoff) + ldsw + _i * 8192), 16, 0, 0); } while (0)
#define PG8_LDA(dst, b, h) do { _Pragma("unroll") for (int m = 0; m < 4; ++m) _Pragma("unroll") for (int k = 0; k < 2; ++k) dst[m][k] = *(const LAS bf16x8*)(lds + PG8_SA(b, h) + aoff + m * 2048 + k * 1024); } while (0)
#define PG8_LDB(dst, b, h) do { _Pragma("unroll") for (int n = 0; n < 2; ++n) _Pragma("unroll") for (int k = 0; k < 2; ++k) dst[n][k] = *(const LAS bf16x8*)(lds + PG8_SB(b, h) + boff + n * 2048 + k * 1024); } while (0)
#define PG8_MMA(ai, bj, At, Bt) do { __builtin_amdgcn_s_setprio(1); _Pragma("unroll") for (int m = 0; m < 4; ++m) _Pragma("unroll") for (int n = 0; n < 2; ++n) _Pragma("unroll") for (int k = 0; k < 2; ++k) \
        acc[ai][bj][m][n] = __builtin_amdgcn_mfma_f32_16x16x32_bf16(Bt[n][k], At[m][k], acc[ai][bj][m][n], 0, 0, 0); __builtin_amdgcn_s_setprio(0); } while (0)
#define PG8_WAIT_V(n) asm volatile("s_waitcnt vmcnt(" #n ")" ::: "memory")
#define PG8_WAIT_L(n) asm volatile("s_waitcnt lgkmcnt(" #n ")" ::: "memory")
#define PG8_BAR __builtin_amdgcn_s_barrier()
#define PG8_SCHED __builtin_amdgcn_sched_barrier(0)
    Unit cur, nxt; int ui = 0;
    if (!S.next(0, cur)) return;
    f32x4 acc[2][2][4][2];
#pragma unroll
    for (int a = 0; a < 2; ++a)
#pragma unroll
        for (int b = 0; b < 2; ++b)
#pragma unroll
            for (int m = 0; m < 4; ++m)
#pragma unroll
                for (int n = 0; n < 2; ++n) acc[a][b][m][n] = (f32x4){0.f, 0.f, 0.f, 0.f};
    bf16x8 At[4][2], B0[2][2], B1[2][2];
    const char* cA = (const char*)g.A + (size_t)cur.pm * tstepA; const char* cB = (const char*)g.Bt + (size_t)cur.pn * tstepB;
    PG8_STAGE(PG8_SB(0, 0), cB, voffB); PG8_STAGE(PG8_SB(0, 1), cB + hstepB, voffB); PG8_STAGE(PG8_SA(0, 0), cA, voffA); PG8_STAGE(PG8_SA(0, 1), cA + hstepA, voffA);
    if (wr == 1) PG8_BAR;
    PG8_WAIT_V(2); PG8_BAR;
    PG8_STAGE(PG8_SB(1, 0), cB + kstep, voffB); PG8_STAGE(PG8_SA(1, 0), cA + kstep, voffA); PG8_STAGE(PG8_SB(1, 1), cB + hstepB + kstep, voffB);
    PG8_WAIT_V(6); PG8_BAR;
    for (;;) {
        const bool has_next = S.next(ui + 1, nxt);
        const char* nA = has_next ? (const char*)g.A + (size_t)nxt.pm * tstepA : cA; const char* nB = has_next ? (const char*)g.Bt + (size_t)nxt.pn * tstepB : cB;
        for (int t = 0; t < nt; t += 2) {
            const bool last = (t == nt - 2);
            const char* a1 = cA + (size_t)(t + 1) * kstep;
            const char* a2 = last ? nA : cA + (size_t)(t + 2) * kstep; const char* b2 = last ? nB : cB + (size_t)(t + 2) * kstep;
            const char* a3 = a2 + kstep; const char* b3 = b2 + kstep;
            PG8_LDB(B0, 0, 0); PG8_LDB(B1, 0, 1); PG8_SCHED; PG8_LDA(At, 0, 0); PG8_STAGE(PG8_SA(1, 1), a1 + hstepA, voffA);
            PG8_WAIT_V(8); PG8_WAIT_L(0); PG8_BAR; PG8_MMA(0, 0, At, B0); PG8_MMA(0, 1, At, B1); PG8_BAR; PG8_SCHED;
            PG8_LDA(At, 0, 1); PG8_STAGE(PG8_SB(0, 0), b2, voffB); PG8_STAGE(PG8_SB(0, 1), b2 + hstepB, voffB); PG8_STAGE(PG8_SA(0, 0), a2, voffA);
            PG8_WAIT_V(8); PG8_WAIT_L(0); PG8_BAR; PG8_MMA(1, 0, At, B0); PG8_MMA(1, 1, At, B1); PG8_BAR; PG8_SCHED;
            PG8_LDB(B0, 1, 0); PG8_LDB(B1, 1, 1); PG8_SCHED; PG8_LDA(At, 1, 0); PG8_STAGE(PG8_SA(0, 1), a2 + hstepA, voffA);
            PG8_WAIT_V(8); PG8_WAIT_L(0); PG8_BAR; PG8_MMA(0, 0, At, B0); PG8_MMA(0, 1, At, B1); PG8_BAR; PG8_SCHED;
            PG8_LDA(At, 1, 1); PG8_STAGE(PG8_SB(1, 0), b3, voffB); PG8_STAGE(PG8_SB(1, 1), b3 + hstepB, voffB); PG8_STAGE(PG8_SA(1, 0), a3, voffA);
            PG8_WAIT_V(8); PG8_WAIT_L(0); PG8_BAR; PG8_MMA(1, 0, At, B0); PG8_MMA(1, 1, At, B1); PG8_BAR; PG8_SCHED;
        }
        if (wr == 0) PG8_BAR;
        { const int l2_ = fresh_tid() & 63; E(acc, cur, wr, wc, l2_ & 15, l2_ >> 4); }
        if (!has_next) break;
#pragma unroll
        for (int a = 0; a < 2; ++a)
#pragma unroll
            for (int b = 0; b < 2; ++b)
#pragma unroll
                for (int m = 0; m < 4; ++m)
#pragma unroll
                    for (int n = 0; n < 2; ++n) acc[a][b][m][n] = (f32x4){0.f, 0.f, 0.f, 0.f};
        cur = nxt; cA = nA; cB = nB; ++ui;
        if (wr == 1) PG8_BAR;
    }
    PG8_WAIT_V(0);
    PG8_BAR;
#undef PG8_SA
#undef PG8_SB
#undef PG8_STAGE
#undef PG8_LDA
#undef PG8_LDB
#undef PG8_MMA
#undef PG8_WAIT_V
#undef PG8_WAIT_L
#undef PG8_BAR
#undef PG8_SCHED
}
typedef const f32x4 (&AccRef)[2][2][4][2];
__device__ __forceinline__ float sq4(const f32x4 v) { return (v[0] * v[0] + v[1] * v[1]) + (v[2] * v[2] + v[3] * v[3]); }
__device__ __forceinline__ u32x4 pack8(const f32x4 a, const f32x4 b) { u32x4 w; w.x = cvtpk(a[0], a[1]); w.y = cvtpk(a[2], a[3]); w.z = cvtpk(b[0], b[1]); w.w = cvtpk(b[2], b[3]); return w; }
__device__ __forceinline__ float fq_sum(float s) { s += __shfl_xor(s, 16); s += __shfl_xor(s, 32); return s; }

struct EpiProj { bf16_t* proj; float* ssq_q; float* ssq_kv; bf16_t* kpe; const float2* rope;
    __device__ __forceinline__ void operator()(AccRef acc, const Unit& u, int wr, int wc, int fr, int fq) const {
        const int row0 = u.pm * BM + wr * 64 + fr, col0 = u.pn * BM + wc * 32 + 8 * fq;
        const float sc = u.pn < 2 ? QSCALE_A : 1.f;
        const bool dorope = (u.pn == 7) && (wc == 0);
        float2 cs[2][4][4];
        if (dorope) {
#pragma unroll
            for (int ai = 0; ai < 2; ++ai)
#pragma unroll
                for (int m = 0; m < 4; ++m) { const int t = (row0 + ai * HALF + m * 16) & (SEQ - 1); const float2* cp = rope + t * 16 + 4 * fq;
#pragma unroll
                    for (int q = 0; q < 4; ++q) cs[ai][m][q] = cp[q]; }
        }
#pragma unroll
        for (int ai = 0; ai < 2; ++ai)
#pragma unroll
            for (int m = 0; m < 4; ++m) { const int row = row0 + ai * HALF + m * 16; bf16_t* rp = proj + (size_t)row * NPROJ + col0;
#pragma unroll
                for (int bj = 0; bj < 2; ++bj) *(u32x4*)(rp + bj * HALF) = pack8(acc[ai][bj][m][0] * sc, acc[ai][bj][m][1] * sc);
                if (u.pn == 6) { float s = (sq4(acc[ai][0][m][0]) + sq4(acc[ai][0][m][1])) + (sq4(acc[ai][1][m][0]) + sq4(acc[ai][1][m][1])); s = fq_sum(s); if (fq == 0) atomicAdd(ssq_q + row, s); }
                if (u.pn == 7) { float s = sq4(acc[ai][0][m][0]) + sq4(acc[ai][0][m][1]); s = fq_sum(s); if (fq == 0) atomicAdd(ssq_kv + row, s);
                    if (wc == 0) { f32x4 a = acc[ai][1][m][0], b = acc[ai][1][m][1];
                        const float2 c0 = cs[ai][m][0], c1 = cs[ai][m][1], c2 = cs[ai][m][2], c3 = cs[ai][m][3];
                        f32x4 ra, rb; ra[0] = a[0] * c0.x - a[1] * c0.y; ra[1] = a[1] * c0.x + a[0] * c0.y; ra[2] = a[2] * c1.x - a[3] * c1.y; ra[3] = a[3] * c1.x + a[2] * c1.y;
                        rb[0] = b[0] * c2.x - b[1] * c2.y; rb[1] = b[1] * c2.x + b[0] * c2.y; rb[2] = b[2] * c3.x - b[3] * c3.y; rb[3] = b[3] * c3.x + b[2] * c3.y;
                        *(u32x4*)(kpe + (size_t)row * 32 + 8 * fq) = pack8(ra, rb); } }
            }
    } };
struct EpiQ { bf16_t* qb; const float* ssq_q; const float2* rope;
    __device__ __forceinline__ void operator()(AccRef acc, const Unit& u, int wr, int wc, int fr, int fq) const {
        const int row0 = u.pm * BM + wr * 64 + fr, col0 = u.pn * BM + wc * 32 + 8 * fq;
        const int w0 = col0 % 96, w1 = (col0 + HALF) % 96; const bool pe0 = w0 >= 64, pe1 = w1 >= 64; const int j0 = pe0 ? (w0 - 64) >> 1 : (pe1 ? (w1 - 64) >> 1 : 0);
        float rr[2][4];
#pragma unroll
        for (int ai = 0; ai < 2; ++ai)
#pragma unroll
            for (int m = 0; m < 4; ++m) rr[ai][m] = ssq_q[row0 + ai * HALF + m * 16];
#pragma unroll
        for (int ai = 0; ai < 2; ++ai) {
            f32x4 cs[4][2];
#pragma unroll
            for (int m = 0; m < 4; ++m) { cs[m][0] = (f32x4){1.f, 0.f, 1.f, 0.f}; cs[m][1] = cs[m][0];
                if (pe0 || pe1) { const f32x4* cp = (const f32x4*)(rope + ((row0 + ai * HALF + m * 16) & (SEQ - 1)) * 16 + j0); cs[m][0] = cp[0]; cs[m][1] = cp[1]; } }
#pragma unroll
            for (int m = 0; m < 4; ++m) asm volatile("" : "+v"(cs[m][0]), "+v"(cs[m][1]));
            __builtin_amdgcn_sched_barrier(0);
#pragma unroll
            for (int m = 0; m < 4; ++m) { const int row = row0 + ai * HALF + m * 16; const float r = rsqrtf(rr[ai][m] * (1.f / 256.f) + EPS);
#pragma unroll
                for (int bj = 0; bj < 2; ++bj) { f32x4 a = acc[ai][bj][m][0] * r, b = acc[ai][bj][m][1] * r;
                    if (bj == 0 ? pe0 : pe1) { const f32x4 ca = cs[m][0], cb = cs[m][1]; f32x4 ra, rb;
                        ra[0] = a[0] * ca[0] - a[1] * ca[1]; ra[1] = a[1] * ca[0] + a[0] * ca[1]; ra[2] = a[2] * ca[2] - a[3] * ca[3]; ra[3] = a[3] * ca[2] + a[2] * ca[3];
                        rb[0] = b[0] * cb[0] - b[1] * cb[1]; rb[1] = b[1] * cb[0] + b[0] * cb[1]; rb[2] = b[2] * cb[2] - b[3] * cb[3]; rb[3] = b[3] * cb[2] + b[2] * cb[3]; a = ra; b = rb; }
                    *(u32x4*)(qb + (size_t)row * NQB + col0 + bj * HALF) = pack8(a * QSCALE_B, b * QSCALE_B); } }
        }
    } };
struct EpiKV { bf16_t* kvb; const float* ssq_kv;
    __device__ __forceinline__ void operator()(AccRef acc, const Unit& u, int wr, int wc, int fr, int fq) const {
        const int row0 = u.pm * BM + wr * 64 + fr, col0 = u.pn * BM + wc * 32 + 8 * fq;
        float rr[2][4];
#pragma unroll
        for (int ai = 0; ai < 2; ++ai)
#pragma unroll
            for (int m = 0; m < 4; ++m) rr[ai][m] = ssq_kv[row0 + ai * HALF + m * 16];
#pragma unroll
        for (int ai = 0; ai < 2; ++ai)
#pragma unroll
            for (int m = 0; m < 4; ++m) { const int row = row0 + ai * HALF + m * 16; const float r = rsqrtf(rr[ai][m] * (1.f / 128.f) + EPS);
#pragma unroll
                for (int bj = 0; bj < 2; ++bj) *(u32x4*)(kvb + (size_t)row * NKVB + col0 + bj * HALF) = pack8(acc[ai][bj][m][0] * r, acc[ai][bj][m][1] * r); }
    } };
__device__ __forceinline__ f32x4 bf4lo(const u32x4 w) { f32x4 r; r[0] = __builtin_bit_cast(float, w.x << 16); r[1] = __builtin_bit_cast(float, w.x & 0xffff0000u); r[2] = __builtin_bit_cast(float, w.y << 16); r[3] = __builtin_bit_cast(float, w.y & 0xffff0000u); return r; }
__device__ __forceinline__ f32x4 bf4hi(const u32x4 w) { f32x4 r; r[0] = __builtin_bit_cast(float, w.z << 16); r[1] = __builtin_bit_cast(float, w.z & 0xffff0000u); r[2] = __builtin_bit_cast(float, w.w << 16); r[3] = __builtin_bit_cast(float, w.w & 0xffff0000u); return r; }
struct EpiOut { const bf16_t* xn; const float* xrs; bf16_t* h1b; float* ssq;
    __device__ __forceinline__ void operator()(AccRef acc, const Unit& u, int wr, int wc, int fr, int fq) const {
        const int row0 = u.pm * BM + wr * 64 + fr, col0 = u.pn * BM + wc * 32 + 8 * fq;
        u32x4 xw[2][4][2]; float rs[2][4];
#pragma unroll
        for (int ai = 0; ai < 2; ++ai)
#pragma unroll
            for (int m = 0; m < 4; ++m) { const int row = row0 + ai * HALF + m * 16; rs[ai][m] = xrs[row];
#pragma unroll
                for (int bj = 0; bj < 2; ++bj) xw[ai][m][bj] = *(const u32x4*)(xn + (size_t)row * DM + col0 + bj * HALF); }
#pragma unroll
        for (int ai = 0; ai < 2; ++ai)
#pragma unroll
            for (int m = 0; m < 4; ++m) { const int row = row0 + ai * HALF + m * 16; const size_t off = (size_t)row * DM + col0; const float r = rs[ai][m]; float s = 0.f;
#pragma unroll
                for (int bj = 0; bj < 2; ++bj) { const f32x4 a = bf4lo(xw[ai][m][bj]) * r + acc[ai][bj][m][0], b = bf4hi(xw[ai][m][bj]) * r + acc[ai][bj][m][1];
                    *(u32x4*)(h1b + off + bj * HALF) = pack8(a, b); s += sq4(a) + sq4(b); }
                s = fq_sum(s); if (fq == 0) atomicAdd(ssq + row, s); }
    } };
struct EpiUp { bf16_t* act; const float* ssq;
    __device__ __forceinline__ void operator()(AccRef acc, const Unit& u, int wr, int wc, int fr, int fq) const {
        const int row0 = u.pm * BM + wr * 64 + fr, col0 = u.pn * BM + wc * 32 + 8 * fq;
        float rr[2][4];
#pragma unroll
        for (int ai = 0; ai < 2; ++ai)
#pragma unroll
            for (int m = 0; m < 4; ++m) rr[ai][m] = ssq[row0 + ai * HALF + m * 16];
#pragma unroll
        for (int ai = 0; ai < 2; ++ai)
#pragma unroll
            for (int m = 0; m < 4; ++m) { const int row = row0 + ai * HALF + m * 16; const float r = rsqrtf(rr[ai][m] * (1.f / DM) + EPS);
#pragma unroll
                for (int bj = 0; bj < 2; ++bj) { f32x4 a = acc[ai][bj][m][0] * r, b = acc[ai][bj][m][1] * r;
#pragma unroll
                    for (int e = 0; e < 4; ++e) { const float ta = fmaxf(a[e], 0.f), tb = fmaxf(b[e], 0.f); a[e] = ta * ta; b[e] = tb * tb; }
                    *(u32x4*)(act + (size_t)row * DFF + col0 + bj * HALF) = pack8(a, b); } }
    } };
struct EpiDown { const bf16_t* h1b; float* h; float* ssq;
    __device__ __forceinline__ void operator()(AccRef acc, const Unit& u, int wr, int wc, int fr, int fq) const {
        const int row0 = u.pm * BM + wr * 64 + fr, col0 = u.pn * BM + wc * 32 + 8 * fq;
#pragma unroll
        for (int ai = 0; ai < 2; ++ai)
#pragma unroll
            for (int m = 0; m < 4; ++m) { const int row = row0 + ai * HALF + m * 16; const size_t off = (size_t)row * DM + col0; float s = 0.f;
#pragma unroll
                for (int bj = 0; bj < 2; ++bj) { const u32x4 hw = *(const u32x4*)(h1b + off + bj * HALF); const f32x4 a = bf4lo(hw) + acc[ai][bj][m][0], b = bf4hi(hw) + acc[ai][bj][m][1];
                    *(f32x4*)(h + off + bj * HALF) = a; *(f32x4*)(h + off + bj * HALF + 4) = b; s += sq4(a) + sq4(b); }
                s = fq_sum(s); if (fq == 0) atomicAdd(ssq + row, s); }
    } };
struct EpiDownFused { const bf16_t* h1b; float* out; const float* gfin; float* xbuf; unsigned* cnt; LAS unsigned char* scr;
    __device__ __forceinline__ void operator()(f32x4 (&acc)[2][2][4][2], const Unit& u, int wr, int wc, int fr, int fq) const {
        LAS float* P = (LAS float*)scr; LAS float* S = (LAS float*)(scr + 4096);
        const int row0 = u.pm * BM + wr * 64 + fr, col0 = u.pn * BM + wc * 32 + 8 * fq;
        u32x4 hw[2][4][2]; f32x4 g[2][2];
#pragma unroll
        for (int ai = 0; ai < 2; ++ai)
#pragma unroll
            for (int m = 0; m < 4; ++m)
#pragma unroll
                for (int bj = 0; bj < 2; ++bj) hw[ai][m][bj] = *(const u32x4*)(h1b + (size_t)(row0 + ai * HALF + m * 16) * DM + col0 + bj * HALF);
#pragma unroll
        for (int bj = 0; bj < 2; ++bj) { g[bj][0] = *(const f32x4*)(gfin + col0 + bj * HALF); g[bj][1] = *(const f32x4*)(gfin + col0 + bj * HALF + 4); }
#pragma unroll
        for (int ai = 0; ai < 2; ++ai)
#pragma unroll
            for (int m = 0; m < 4; ++m) { float s = 0.f;
#pragma unroll
                for (int bj = 0; bj < 2; ++bj) { acc[ai][bj][m][0] += bf4lo(hw[ai][m][bj]); acc[ai][bj][m][1] += bf4hi(hw[ai][m][bj]); s += sq4(acc[ai][bj][m][0]) + sq4(acc[ai][bj][m][1]); }
                s = fq_sum(s); if (fq == 0) P[(ai * HALF + wr * 64 + m * 16 + fr) * 4 + wc] = s; }
        asm volatile("s_waitcnt lgkmcnt(0)\n\ts_barrier" ::: "memory");
        const int t = threadIdx.x;
        if (t < 256) { const float tot = (P[t * 4] + P[t * 4 + 1]) + (P[t * 4 + 2] + P[t * 4 + 3]);
            __hip_atomic_store(xbuf + (size_t)(u.pm * BM + t) * 4 + u.pn, tot, __ATOMIC_RELAXED, __HIP_MEMORY_SCOPE_AGENT); }
        asm volatile("s_waitcnt vmcnt(0)" ::: "memory");
        if (t < 256 && (t & 63) == 0) __hip_atomic_fetch_add(cnt + 64 * u.pm, 1u, __ATOMIC_RELAXED, __HIP_MEMORY_SCOPE_AGENT);
        if (t < 64) { unsigned spins = 0;
            while ((unsigned)__builtin_amdgcn_readfirstlane(__hip_atomic_load(cnt + 64 * u.pm, __ATOMIC_RELAXED, __HIP_MEMORY_SCOPE_AGENT)) < 16u) { __builtin_amdgcn_s_sleep(1); if (++spins > (1u << 22)) break; }
            __builtin_amdgcn_fence(__ATOMIC_ACQUIRE, "agent"); }
        asm volatile("s_waitcnt vmcnt(0) lgkmcnt(0)\n\ts_barrier" ::: "memory");
        if (t < 256) { const float* sl = xbuf + (size_t)(u.pm * BM + t) * 4; float tot = 0.f;
#pragma unroll
            for (int q = 0; q < 4; ++q) tot += __hip_atomic_load(sl + q, __ATOMIC_RELAXED, __HIP_MEMORY_SCOPE_AGENT);
            S[t] = rsqrtf(tot * (1.f / DM) + EPS); }
        asm volatile("s_waitcnt vmcnt(0) lgkmcnt(0)\n\ts_barrier" ::: "memory");
#pragma unroll
        for (int ai = 0; ai < 2; ++ai)
#pragma unroll
            for (int m = 0; m < 4; ++m) { const int rl = ai * HALF + wr * 64 + m * 16 + fr; const float r = S[rl]; const size_t off = (size_t)(u.pm * BM + rl) * DM + col0;
#pragma unroll
                for (int bj = 0; bj < 2; ++bj) { *(f32x4*)(out + off + bj * HALF) = acc[ai][bj][m][0] * g[bj][0] * r; *(f32x4*)(out + off + bj * HALF + 4) = acc[ai][bj][m][1] * g[bj][1] * r; } }
        asm volatile("s_waitcnt lgkmcnt(0)\n\ts_barrier" ::: "memory");
    } };
}

namespace mla {
constexpr int KPITCH = 208, KBUF = 64 * KPITCH, VBUF = 8192;
constexpr int OFF_K = 0, OFF_V = 2 * KBUF, LDS_NEED = 2 * KBUF + 3 * VBUF;
constexpr int NT = SEQ / 64;
constexpr float THR = 8.0f;
constexpr float PTHR = 256.0f;
#define MSB() __builtin_amdgcn_sched_barrier(0)
#define MPIN(x) asm volatile("" : "+v"(x))
#define MX3(a, b, c) __builtin_fmaxf(__builtin_fmaxf((a), (b)), (c))
#define MFMA32(a, b, c) __builtin_amdgcn_mfma_f32_32x32x16_bf16((a), (b), (c), 0, 0, 0)
#define LBAR() do { if (VAR != 1 && VAR != 10 && VAR != 11) asm volatile("s_waitcnt lgkmcnt(0)\n\ts_barrier" ::: "memory"); } while (0)
__device__ __forceinline__ float swapmax(float v) { auto rr = __builtin_amdgcn_permlane32_swap(__float_as_uint(v), __float_as_uint(v), false, false); return __builtin_fmaxf(__uint_as_float(rr[0]), __uint_as_float(rr[1])); }
__device__ __forceinline__ float swapsum(float v) { auto rr = __builtin_amdgcn_permlane32_swap(__float_as_uint(v), __float_as_uint(v), false, false); return __uint_as_float(rr[0]) + __uint_as_float(rr[1]); }
template <int VAR> __device__ __forceinline__ bf16x8 kfrag_(const LAS unsigned char* p, const bf16x8 dummy) { if (VAR == 5 || VAR == 7 || VAR == 10 || VAR == 11) { bf16x8 d = dummy; asm volatile("" : "+v"(d)); return d; } return *(const LAS bf16x8*)p; }
template <int VAR> __device__ __forceinline__ bf16x8 vfrag_(const LAS unsigned char* p, const bf16x8 dummy) { if (VAR == 6 || VAR == 7 || VAR == 10 || VAR == 11) { bf16x8 d = dummy; asm volatile("" : "+v"(d)); return d; } const s16x4 lo = tr16(p), hi = tr16(p + 1024); return __builtin_shufflevector(lo, hi, 0, 1, 2, 3, 4, 5, 6, 7); }
#define kfrag(p) kfrag_<VAR>((p), qr[0])
#define vfrag(p) vfrag_<VAR>((p), qr[1])

__device__ __forceinline__ f32x16 pinacc(f32x16 c, bf16x8 a, bf16x8 b) { asm volatile("" : "+v"(c) : "v"(a), "v"(b)); return c; }
template <int VAR>
__device__ __forceinline__ void unit(LAS unsigned char* lds, int b, int h, int qblk, const bf16_t* __restrict__ Q, const bf16_t* __restrict__ KV, const bf16_t* __restrict__ KPE, bf16_t* __restrict__ O) {
    if (VAR == 12) return;
    constexpr int NT = (VAR == 13) ? mla::NT / 2 : ((VAR == 14) ? 4 : mla::NT);
    const int tid = fresh_tid(), lane = tid & 63, wid = __builtin_amdgcn_readfirstlane(tid >> 6), r32 = lane & 31, hi = lane >> 5;
    const size_t row0 = (size_t)b * SEQ;
    const int srow = tid >> 3, sch = tid & 7;
    const bf16_t* srcA = KV + (row0 + srow) * NKVB + 128 * h + 8 * sch;
    const bf16_t* srcB = srcA + 64;
    const bf16_t* srcC = KPE + (row0 + (tid >> 2)) * 32 + 8 * (tid & 3);
    const int dstA = OFF_K + srow * KPITCH + sch * 16;
    const int dstB = OFF_V + ((srow >> 3) * 2 + (sch >> 2)) * 512 + (srow & 7) * 64 + (sch & 3) * 16;
    const int dstC = OFF_K + (tid >> 2) * KPITCH + 128 + (tid & 3) * 16;
    const bool hasC = tid < 256;
    constexpr size_t TSA = (size_t)64 * NKVB, TSC = (size_t)64 * 32;
    u32x4 a0, b0, c0 = (u32x4){0u, 0u, 0u, 0u}, a1, b1, c1 = (u32x4){0u, 0u, 0u, 0u};
    { const u32x4 ka = *(const u32x4*)srcA; u32x4 kc = (u32x4){0u, 0u, 0u, 0u}; if (hasC) kc = *(const u32x4*)srcC;
      a0 = *(const u32x4*)(srcA + TSA); b0 = *(const u32x4*)srcB; if (hasC) c0 = *(const u32x4*)(srcC + TSC);
      a1 = *(const u32x4*)(srcA + 2 * TSA); b1 = *(const u32x4*)(srcB + TSA); if (hasC) c1 = *(const u32x4*)(srcC + 2 * TSC);
      *(LAS u32x4*)(lds + dstA) = ka; if (hasC) *(LAS u32x4*)(lds + dstC) = kc; }
    const bf16_t* qp = Q + (row0 + qblk * 256 + wid * 32 + r32) * NQB + 96 * h + 8 * hi;
    bf16x8 qr[6];
#pragma unroll
    for (int s = 0; s < 6; ++s) qr[s] = *(const bf16x8*)(qp + 16 * s);
    f32x16 o0, o1, negm, pA0, pA1, pB0, pB1;
#pragma unroll
    for (int i = 0; i < 16; ++i) { o0[i] = 0.f; o1[i] = 0.f; negm[i] = 0.f; }
    MPIN(negm);
    float mref = 0.f, lrun = 0.f, fres = 1.f; bool resc = false;
    const LAS unsigned char* kf0 = lds + OFF_K + r32 * KPITCH + 16 * hi;
    const LAS unsigned char* vf0 = lds + OFF_V + (4 * hi + ((lane & 15) >> 2)) * 64 + ((lane >> 4) & 1) * 32 + (lane & 3) * 8;
    LBAR();
    u32x4 pw0, pw1, pw2, pw3;
#define PKW(P, B) cvtpk(P[B], P[B + 1])
#define PAF(k) __builtin_bit_cast(bf16x8, pw##k)
#define KFC(f) kfrag(kp_ + ((f) & 1) * 32 * KPITCH + 32 * ((f) >> 1))
#define KFN(f) kfrag(kn_ + ((f) & 1) * 32 * KPITCH + 32 * ((f) >> 1))
#define SUM4(P, B) do { if (VAR == 4 || VAR == 10 || VAR == 11) break; sacc += P[B]; sacc += P[B + 1]; sacc += P[B + 2]; sacc += P[B + 3]; MPIN(sacc); } while (0)
#define PK2(PW, i, P, B) do { PW[i] = PKW(P, B); PW[(i) + 1] = PKW(P, (B) + 2); MPIN(PW); } while (0)
#define STAGE_K(SA, SC, s) do { if (VAR == 3 || VAR == 10 || VAR == 11) break; const int kw_ = (((s) + 1) & 1) * KBUF; *(LAS u32x4*)(lds + kw_ + dstA) = SA; if (hasC) *(LAS u32x4*)(lds + kw_ + dstC) = SC; \
        const int tk_ = (s) + 3 < NT ? (s) + 3 : NT - 1; SA = *(const u32x4*)(srcA + (size_t)tk_ * TSA); if (hasC) SC = *(const u32x4*)(srcC + (size_t)tk_ * TSC); } while (0)
#define STAGE_V(SB, s) do { if (VAR == 3 || VAR == 10 || VAR == 11) break; *(LAS u32x4*)(lds + vslot * VBUF + dstB) = SB; const int tv_ = (s) + 2 < NT ? (s) + 2 : NT - 1; SB = *(const u32x4*)(srcB + (size_t)tv_ * TSA); } while (0)
#define DECIDE(C0, C1) do { float a_ = MX3(C0[0], C0[1], C1[0]), b_ = MX3(C0[2], C0[3], C1[1]); a_ = MX3(a_, C1[2], C1[3]); \
        _Pragma("unroll") for (int r = 4; r < 16; r += 4) { a_ = MX3(a_, C0[r], C0[r + 1]); b_ = MX3(b_, C0[r + 2], C0[r + 3]); a_ = MX3(a_, C1[r], C1[r + 1]); b_ = MX3(b_, C1[r + 2], C1[r + 3]); } \
        const float rm_ = swapmax(__builtin_fmaxf(a_, b_)); resc = false; \
        if (__builtin_expect(__any(rm_ > THR), 0)) { const float dl_ = __builtin_fmaxf(rm_, 0.f); mref += dl_; \
            _Pragma("unroll") for (int r = 0; r < 16; ++r) { C0[r] -= dl_; C1[r] -= dl_; } \
            _Pragma("unroll") for (int r = 0; r < 16; ++r) negm[r] = -mref; MPIN(negm); \
            fres = __builtin_amdgcn_exp2f(-dl_); lrun *= fres; resc = true; } } while (0)
#define EXP4(X, B) do { if (VAR == 2 || VAR == 10 || VAR == 11) { MPIN(X); break; } X[B] = __builtin_amdgcn_exp2f(X[B]); X[B + 1] = __builtin_amdgcn_exp2f(X[B + 1]); X[B + 2] = __builtin_amdgcn_exp2f(X[B + 2]); X[B + 3] = __builtin_amdgcn_exp2f(X[B + 3]); MPIN(X); } while (0)
#define LAGDECIDE(P0, P1, N0, N1, M) do { const float rm_ = swapmax(M); resc = false;   \
        if (__builtin_expect(__any(rm_ > PTHR), 0)) { const float dl_ = __builtin_fmaxf(__builtin_amdgcn_logf(rm_), 0.f); fres = __builtin_amdgcn_exp2f(-dl_); mref += dl_; \
            _Pragma("unroll") for (int r = 0; r < 16; ++r) { N0[r] -= dl_; N1[r] -= dl_; negm[r] = -mref; } MPIN(negm); \
            lrun *= fres; resc = true; } } while (0)
#define MFMAB(a, b, c) ((VAR == 8 || VAR == 11) ? pinacc(c, a, b) : MFMA32(a, b, c))
#define MFMAA(a, b, c) ((VAR == 9 || VAR == 11) ? pinacc(c, a, b) : MFMA32(a, b, c))
#define EXP1(X, i) X[i] = __builtin_amdgcn_exp2f(X[i])
#define EXP3(X, a, Y, b, Z, c) do { if (VAR == 2 || VAR == 10 || VAR == 11) { MPIN(X); break; } EXP1(X, a); EXP1(Y, b); EXP1(Z, c); MPIN(X); MPIN(Y); MPIN(Z); } while (0)
#define EXP2(X, a, Y, b) do { if (VAR == 2 || VAR == 10 || VAR == 11) { MPIN(X); break; } EXP1(X, a); EXP1(Y, b); MPIN(X); MPIN(Y); } while (0)
#define STEP(N0, N1, P0, P1, SA, SB, SC, s) do { \
        STAGE_K(SA, SC, s); STAGE_V(SB, s); MSB(); \
        const LAS unsigned char* kp_ = kf0 + ((s) & 1) * KBUF; const LAS unsigned char* kn_ = kf0 + (((s) + 1) & 1) * KBUF; const LAS unsigned char* vp_ = vf0 + vprev * VBUF; \
        bf16x8 v0_, v1_, v2_, v3_; float sacc = 0.f; \
        N0 = MFMAA(k4, qr[2], N0); k4 = KFC(10); SUM4(P0, 0);  PK2(pw0, 0, P0, 0);  MSB(); \
        N1 = MFMAA(k5, qr[2], N1); k5 = KFC(11); SUM4(P0, 4);  PK2(pw0, 2, P0, 4);  MSB(); \
        N0 = MFMAA(k0, qr[3], N0);               SUM4(P0, 8);  PK2(pw1, 0, P0, 8);  MSB(); \
        N1 = MFMAA(k1, qr[3], N1);               SUM4(P0, 12); PK2(pw1, 2, P0, 12); MSB(); \
        N0 = MFMAA(k2, qr[4], N0); v0_ = vfrag(vp_);       SUM4(P1, 0);  PK2(pw2, 0, P1, 0);  MSB(); \
        N1 = MFMAA(k3, qr[4], N1); v1_ = vfrag(vp_ + 512); SUM4(P1, 4);  PK2(pw2, 2, P1, 4);  MSB(); \
        N0 = MFMAA(k4, qr[5], N0); v2_ = vfrag(vp_ + 2048);       SUM4(P1, 8);  PK2(pw3, 0, P1, 8);  MSB(); \
        N1 = MFMAA(k5, qr[5], N1); v3_ = vfrag(vp_ + 2048 + 512); SUM4(P1, 12); PK2(pw3, 2, P1, 12); MSB(); \
        lrun += sacc; \
        LAGDECIDE(P0, P1, N0, N1, sacc); MSB(); \
        LBAR(); \
        vprev = vslot; vslot = (vslot == 2) ? 0 : vslot + 1; \
        k0 = KFN(0); k1 = KFN(1); MSB(); \
        o0 = MFMAB(v0_, PAF(0), o0); v0_ = vfrag(vp_ + 4096);       k2 = KFN(2); EXP3(N0, 0, N0, 1, N0, 2);    MSB(); \
        o1 = MFMAB(v1_, PAF(0), o1); v1_ = vfrag(vp_ + 4096 + 512); k3 = KFN(3); EXP3(N0, 3, N0, 4, N0, 5);    MSB(); \
        o0 = MFMAB(v2_, PAF(1), o0); v2_ = vfrag(vp_ + 6144);       k4 = KFN(4); EXP3(N0, 6, N0, 7, N0, 8);    MSB(); \
        o1 = MFMAB(v3_, PAF(1), o1); v3_ = vfrag(vp_ + 6144 + 512); k5 = KFN(5); EXP3(N0, 9, N0, 10, N0, 11); MSB(); \
        o0 = MFMAB(v0_, PAF(2), o0); EXP3(N0, 12, N0, 13, N0, 14); MSB(); \
        o1 = MFMAB(v1_, PAF(2), o1); EXP3(N0, 15, N1, 0, N1, 1);   MSB(); \
        o0 = MFMAB(v2_, PAF(3), o0); EXP3(N1, 2, N1, 3, N1, 4); MSB(); \
        o1 = MFMAB(v3_, PAF(3), o1); EXP3(N1, 5, N1, 6, N1, 7); MSB(); \
        P0 = MFMAA(k0, qr[0], negm); k0 = KFN(6); EXP2(N1, 8, N1, 9);   MSB(); \
        P1 = MFMAA(k1, qr[0], negm); k1 = KFN(7); EXP2(N1, 10, N1, 11); MSB(); \
        P0 = MFMAA(k2, qr[1], P0);   k2 = KFN(8); EXP2(N1, 12, N1, 13); MSB(); \
        P1 = MFMAA(k3, qr[1], P1);   k3 = KFN(9); EXP2(N1, 14, N1, 15); MSB(); \
        if (resc) { _Pragma("unroll") for (int r = 0; r < 16; ++r) { o0[r] *= fres; o1[r] *= fres; } } \
        } while (0)
#define QK2(C0, C1, ds, INIT) do { const bf16x8 ka_ = kfrag(kp_ + 32 * (ds)), kb_ = kfrag(kp_ + 32 * KPITCH + 32 * (ds)); \
        C0 = MFMA32(ka_, qr[ds], INIT ? negm : C0); C1 = MFMA32(kb_, qr[ds], INIT ? negm : C1); } while (0)
    bf16x8 k0, k1, k2, k3, k4, k5;
    int vslot = 0, vprev = 0;
    {
        STAGE_K(a0, c0, 0); STAGE_V(b0, 0); MSB();
        const LAS unsigned char* kp_ = kf0; const LAS unsigned char* kn_ = kf0 + KBUF;
        QK2(pA0, pA1, 0, true); QK2(pA0, pA1, 1, false); QK2(pA0, pA1, 2, false); QK2(pA0, pA1, 3, false); QK2(pA0, pA1, 4, false); QK2(pA0, pA1, 5, false);
        float a_ = MX3(pA0[0], pA0[1], pA1[0]), b_ = MX3(pA0[2], pA0[3], pA1[1]); a_ = MX3(a_, pA1[2], pA1[3]);
#pragma unroll
        for (int r = 4; r < 16; r += 4) { a_ = MX3(a_, pA0[r], pA0[r + 1]); b_ = MX3(b_, pA0[r + 2], pA0[r + 3]); a_ = MX3(a_, pA1[r], pA1[r + 1]); b_ = MX3(b_, pA1[r + 2], pA1[r + 3]); }
        const float rm_ = swapmax(__builtin_fmaxf(a_, b_));
        mref = rm_;
#pragma unroll
        for (int r = 0; r < 16; ++r) { pA0[r] = __builtin_amdgcn_exp2f(pA0[r] - rm_); pA1[r] = __builtin_amdgcn_exp2f(pA1[r] - rm_); negm[r] = -mref; }
        MPIN(negm);
        LBAR();
        vprev = vslot; vslot = 1;
        k0 = KFN(0); k1 = KFN(1); k2 = KFN(2); k3 = KFN(3); k4 = KFN(4); k5 = KFN(5);
        pB0 = MFMA32(k0, qr[0], negm); pB1 = MFMA32(k1, qr[0], negm); pB0 = MFMA32(k2, qr[1], pB0); pB1 = MFMA32(k3, qr[1], pB1);
        k0 = KFN(6); k1 = KFN(7); k2 = KFN(8); k3 = KFN(9);
    }
    for (int s = 1; s + 1 < NT; s += 2) {
        STEP(pB0, pB1, pA0, pA1, a1, b1, c1, s);
        STEP(pA0, pA1, pB0, pB1, a0, b0, c0, s + 1);
    }
    STEP(pB0, pB1, pA0, pA1, a1, b1, c1, NT - 1);
    LBAR();
    {
        float sacc = 0.f;
#pragma unroll
        for (int r = 0; r < 16; ++r) sacc += pB0[r] + pB1[r];
        lrun += sacc;
        pw0 = (u32x4){PKW(pB0, 0), PKW(pB0, 2), PKW(pB0, 4), PKW(pB0, 6)}; pw1 = (u32x4){PKW(pB0, 8), PKW(pB0, 10), PKW(pB0, 12), PKW(pB0, 14)};
        pw2 = (u32x4){PKW(pB1, 0), PKW(pB1, 2), PKW(pB1, 4), PKW(pB1, 6)}; pw3 = (u32x4){PKW(pB1, 8), PKW(pB1, 10), PKW(pB1, 12), PKW(pB1, 14)};
        const LAS unsigned char* vp_ = vf0 + vprev * VBUF;
        { const bf16x8 v0_ = vfrag(vp_), v1_ = vfrag(vp_ + 512); o0 = MFMA32(v0_, PAF(0), o0); o1 = MFMA32(v1_, PAF(0), o1); }
        { const bf16x8 v0_ = vfrag(vp_ + 2048), v1_ = vfrag(vp_ + 2048 + 512); o0 = MFMA32(v0_, PAF(1), o0); o1 = MFMA32(v1_, PAF(1), o1); }
        { const bf16x8 v0_ = vfrag(vp_ + 4096), v1_ = vfrag(vp_ + 4096 + 512); o0 = MFMA32(v0_, PAF(2), o0); o1 = MFMA32(v1_, PAF(2), o1); }
        { const bf16x8 v0_ = vfrag(vp_ + 6144), v1_ = vfrag(vp_ + 6144 + 512); o0 = MFMA32(v0_, PAF(3), o0); o1 = MFMA32(v1_, PAF(3), o1); }
    }
    lrun = swapsum(lrun);
    const float inv = 1.f / lrun;
    bf16_t* op = O + (row0 + qblk * 256 + wid * 32 + r32) * DM + 512 + 64 * h + 4 * hi;
#pragma unroll
    for (int i = 0; i < 4; ++i) {
        u32x2 w; w.x = cvtpk(o0[4 * i] * inv, o0[4 * i + 1] * inv); w.y = cvtpk(o0[4 * i + 2] * inv, o0[4 * i + 3] * inv); *(u32x2*)(op + 8 * i) = w;
        u32x2 z; z.x = cvtpk(o1[4 * i] * inv, o1[4 * i + 1] * inv); z.y = cvtpk(o1[4 * i + 2] * inv, o1[4 * i + 3] * inv); *(u32x2*)(op + 32 + 8 * i) = z;
    }
    LBAR();
#undef PKW
#undef PAF
#undef STAGE_K
#undef STAGE_V
#undef QK2
#undef SUM4
#undef PK2
#undef KFC
#undef KFN
#undef DECIDE
#undef LAGDECIDE
#undef EXP4
#undef EXP1
#undef EXP2
#undef EXP3
#undef STEP
}
#undef kfrag
#undef vfrag
#undef MSB
#undef MPIN
#undef MX3
#undef MFMA32
#undef LBAR
}

namespace dil {
constexpr int EXT_OFF1 = 176, EXT_OFF2 = 428, EXT_H = 1052;
constexpr float THR = 8.0f;
constexpr int ROWB = NPROJ * 2;
__device__ __forceinline__ void build_ext(LAS float* ext, const float* __restrict__ rel_bias) {
    for (int i = threadIdx.x; i < 8 * EXT_H; i += NTHREADS) { const int h = i / EXT_H, k = i % EXT_H;
        int d, j; if (k < EXT_OFF1) { d = 16; j = k - 79; } else if (k < EXT_OFF2) { d = 4; j = k - EXT_OFF1 - 124; } else { d = 1; j = k - EXT_OFF2 - 304; }
        ext[i] = (j >= -64 && j <= 64) ? rel_bias[t5_bucket(d * j) * 8 + h] * LOG2E : -__builtin_inff(); }
}
struct Frags { u32x4 k0, k1, k2, k3; u32x4 v0, v1, v2, v3; };
template <int LD>
struct Pat {
    static constexpr int D = 1 << LD, QS = 16 >> LD, LMAX = SEQ >> LD;
    static __device__ __forceinline__ void load(Frags& f, const bf16_t* __restrict__ prow, int Lb, int rem, int c, unsigned offK, unsigned offV, int vrow, unsigned kcol, unsigned vcol) {
        const int lbase = Lb - 64 + 32 * c;
        if (lbase >= 0 && lbase + 31 < LMAX) {
            const char* ub = (const char*)prow + (size_t)((lbase << LD) + rem) * ROWB;
            constexpr size_t R8 = (size_t)(8 << LD) * ROWB;
            f.k0 = *(const u32x4*)(ub + offK); f.k1 = *(const u32x4*)(ub + offK + R8); f.k2 = *(const u32x4*)(ub + offK + 2 * R8); f.k3 = *(const u32x4*)(ub + offK + 3 * R8);
            f.v0 = *(const u32x4*)(ub + offV); f.v1 = *(const u32x4*)(ub + offV + R8); f.v2 = *(const u32x4*)(ub + offV + 2 * R8); f.v3 = *(const u32x4*)(ub + offV + 3 * R8);
        } else {
            auto rowp = [&](int l) { l = l < 0 ? 0 : (l > LMAX - 1 ? LMAX - 1 : l); return (const char*)prow + (size_t)((l << LD) + rem) * ROWB; };
            const char* r0 = rowp(lbase + vrow); const char* r1 = rowp(lbase + vrow + 8); const char* r2 = rowp(lbase + vrow + 16); const char* r3 = rowp(lbase + vrow + 24);
            f.k0 = *(const u32x4*)(r0 + kcol); f.k1 = *(const u32x4*)(r1 + kcol); f.k2 = *(const u32x4*)(r2 + kcol); f.k3 = *(const u32x4*)(r3 + kcol);
            f.v0 = *(const u32x4*)(r0 + vcol); f.v1 = *(const u32x4*)(r1 + vcol); f.v2 = *(const u32x4*)(r2 + vcol); f.v3 = *(const u32x4*)(r3 + vcol);
        }
    }
    static __device__ __forceinline__ void compute(const Frags& f, LAS unsigned char* kw, LAS unsigned char* kwx, const LAS unsigned char* kr, const LAS unsigned char* krx, LAS unsigned char* vw, const LAS unsigned char* (&vr)[4], const LAS float* tb, int Lb, int c, int fq, const bf16x8 (&qf)[2], f32x4 (&oacc)[4], float& mref, float& lrun) {
        const int lbase = Lb - 64 + 32 * c;
        *(LAS u32x4*)(kw) = f.k0; *(LAS u32x4*)(kwx + 8 * 128) = f.k1; *(LAS u32x4*)(kw + 16 * 128) = f.k2; *(LAS u32x4*)(kwx + 24 * 128) = f.k3;
        *(LAS u32x4*)(vw) = f.v0; *(LAS u32x4*)(vw + 8 * 32) = f.v1; *(LAS u32x4*)(vw + 16 * 32) = f.v2; *(LAS u32x4*)(vw + 24 * 32) = f.v3;
        const LAS float* t = tb + 32 * c;
        f32x4 sa = {t[0], t[1], t[2], t[3]}, sb = {t[16], t[17], t[18], t[19]};
        if (!(lbase >= 0 && lbase + 31 < LMAX)) {
            const float NEG = -__builtin_inff();
#pragma unroll
            for (int e = 0; e < 4; ++e) { const int la = lbase + 4 * fq + e, lb2 = la + 16; if (la < 0 || la >= LMAX) sa[e] = NEG; if (lb2 < 0 || lb2 >= LMAX) sb[e] = NEG; }
        }
        const bf16x8 k00 = *(const LAS bf16x8*)kr, k01 = *(const LAS bf16x8*)krx, k10 = *(const LAS bf16x8*)(kr + 16 * 128), k11 = *(const LAS bf16x8*)(krx + 16 * 128);
        sa = __builtin_amdgcn_mfma_f32_16x16x32_bf16(k00, qf[0], sa, 0, 0, 0); sa = __builtin_amdgcn_mfma_f32_16x16x32_bf16(k01, qf[1], sa, 0, 0, 0);
        sb = __builtin_amdgcn_mfma_f32_16x16x32_bf16(k10, qf[0], sb, 0, 0, 0); sb = __builtin_amdgcn_mfma_f32_16x16x32_bf16(k11, qf[1], sb, 0, 0, 0);
        const float lm = __builtin_fmaxf(__builtin_fmaxf(__builtin_fmaxf(sa[0], sa[1]), __builtin_fmaxf(sa[2], sa[3])), __builtin_fmaxf(__builtin_fmaxf(sb[0], sb[1]), __builtin_fmaxf(sb[2], sb[3])));
        if (__any(lm > mref + THR)) {
            float rm = __builtin_fmaxf(lm, __shfl_xor(lm, 16)); rm = __builtin_fmaxf(rm, __shfl_xor(rm, 32));
            const float mnew = __builtin_fmaxf(mref, rm), alpha = __builtin_amdgcn_exp2f(mref - mnew);
            lrun *= alpha;
#pragma unroll
            for (int d = 0; d < 4; ++d) oacc[d] = oacc[d] * alpha;
            mref = mnew;
        }
        float ls = 0.f;
#pragma unroll
        for (int e = 0; e < 4; ++e) { sa[e] = __builtin_amdgcn_exp2f(sa[e] - mref); sb[e] = __builtin_amdgcn_exp2f(sb[e] - mref); ls += sa[e] + sb[e]; }
        lrun += ls;
        u32x4 pw; pw.x = cvtpk(sa[0], sa[1]); pw.y = cvtpk(sa[2], sa[3]); pw.z = cvtpk(sb[0], sb[1]); pw.w = cvtpk(sb[2], sb[3]);
        const bf16x8 pk = __builtin_bit_cast(bf16x8, pw);
#pragma unroll
        for (int d = 0; d < 4; ++d) { const s16x4 lo = tr16(vr[d]), hi = tr16(vr[d] + 512);
            const bf16x8 va = __builtin_shufflevector(lo, hi, 0, 1, 2, 3, 4, 5, 6, 7);
            oacc[d] = __builtin_amdgcn_mfma_f32_16x16x32_bf16(va, pk, oacc[d], 0, 0, 0); }
    }
    template <int NSTEP>
    static __device__ __forceinline__ void run(LAS unsigned char* kw, LAS unsigned char* kwx, const LAS unsigned char* kr, const LAS unsigned char* krx, LAS unsigned char* vw, const LAS unsigned char* (&vr)[4], const LAS float* ext_h, const bf16_t* __restrict__ prow, int t0, int lane, unsigned kcol, unsigned vcol, const bf16x8 (&qf)[2], f32x4 (&oacc)[4], float& mref, float& lrun) {
        const int i16 = lane & 15, fq = lane >> 4, vrow = lane >> 3;
        const int Lb = __builtin_amdgcn_readfirstlane(t0 >> LD), rem = __builtin_amdgcn_readfirstlane(t0 & (D - 1));
        const unsigned offK = (unsigned)(vrow << LD) * ROWB + kcol, offV = (unsigned)(vrow << LD) * ROWB + vcol;
        const LAS float* tb = ext_h + (LD == 4 ? 0 : (LD == 2 ? EXT_OFF1 : EXT_OFF2)) + 15 * QS + 4 * fq - QS * i16;
        Frags A, B;
        load(A, prow, Lb, rem, 0, offK, offV, vrow, kcol, vcol);
        int c = 0;
#pragma unroll 1
        for (; c + 1 < NSTEP; c += 2) {
            load(B, prow, Lb, rem, c + 1, offK, offV, vrow, kcol, vcol);
            compute(A, kw, kwx, kr, krx, vw, vr, tb, Lb, c, fq, qf, oacc, mref, lrun);
            if (c + 2 < NSTEP) load(A, prow, Lb, rem, c + 2, offK, offV, vrow, kcol, vcol);
            compute(B, kw, kwx, kr, krx, vw, vr, tb, Lb, c + 1, fq, qf, oacc, mref, lrun);
        }
        if (NSTEP & 1) compute(A, kw, kwx, kr, krx, vw, vr, tb, Lb, NSTEP - 1, fq, qf, oacc, mref, lrun);
    }
};
constexpr int SH_PITCH = 160, SH_TILE = 40 * SH_PITCH, SH_BUF = 2 * SH_TILE;
template <int DV>
__device__ __forceinline__ void p1_shared(LAS unsigned char* sh, const LAS float* ext_h, const bf16_t* __restrict__ prow, int h, int T, int w, int lane, const bf16x8 (&qf)[2], f32x4 (&oacc)[4], float& mref, float& lrun) {
    constexpr int NSTEP = (DV == 6) ? 6 : 12;
    const int tid = threadIdx.x, i16 = lane & 15, fq = lane >> 4;
    const int r0 = tid >> 4, c0 = tid & 15; const bool two = tid < 128; const int r1 = (tid + 512) >> 4;
    const unsigned col0 = (unsigned)((c0 < 8 ? COL_KA : COL_VA - 64) + 64 * h + 8 * c0) * 2u;
    const int d0 = (c0 < 8 ? 0 : SH_TILE) + r0 * SH_PITCH + (c0 & 7) * 16, d1 = (c0 < 8 ? 0 : SH_TILE) + r1 * SH_PITCH + (c0 & 7) * 16;
    auto ld = [&](int c, int row) { int p = T - 64 + 32 * c + row; p = p < 0 ? 0 : (p > SEQ - 1 ? SEQ - 1 : p); return *(const u32x4*)((const char*)prow + (size_t)p * ROWB + col0); };
    u32x4 ga = ld(0, r0), gb = (u32x4){0u, 0u, 0u, 0u}, ha, hb = (u32x4){0u, 0u, 0u, 0u}; if (two) gb = ld(0, r1);
    __syncthreads();
    *(LAS u32x4*)(sh + d0) = ga; if (two) *(LAS u32x4*)(sh + d1) = gb;
    ga = ld(1, r0); if (two) gb = ld(1, r1);
    ha = ld(2, r0); if (two) hb = ld(2, r1);
    const LAS float* tb = ext_h + EXT_OFF2 + 15 * 16 + 4 * fq - 16 * i16;
    const int kro = (w + i16) * SH_PITCH + fq * 16, vro = SH_TILE + (w + 4 * fq + (i16 >> 2)) * SH_PITCH + (i16 & 3) * 8;
    asm volatile("s_waitcnt lgkmcnt(0)\n\ts_barrier" ::: "memory");
#pragma unroll 1
    for (int c = 0; c < NSTEP; ++c) {
        const LAS unsigned char* bufp = sh + (c & 1) * SH_BUF;
        const int lbase = T + w - 64 + 32 * c;
        const LAS float* t = tb + 32 * c;
        f32x4 sa = {t[0], t[1], t[2], t[3]}, sb = {t[16], t[17], t[18], t[19]};
        if (!(lbase >= 0 && lbase + 31 < SEQ)) { const float NEG = -__builtin_inff();
#pragma unroll
            for (int e = 0; e < 4; ++e) { const int la = lbase + 4 * fq + e, lb2 = la + 16; if (la < 0 || la >= SEQ) sa[e] = NEG; if (lb2 < 0 || lb2 >= SEQ) sb[e] = NEG; } }
        const bf16x8 k00 = *(const LAS bf16x8*)(bufp + kro), k01 = *(const LAS bf16x8*)(bufp + kro + 64), k10 = *(const LAS bf16x8*)(bufp + kro + 16 * SH_PITCH), k11 = *(const LAS bf16x8*)(bufp + kro + 16 * SH_PITCH + 64);
        sa = __builtin_amdgcn_mfma_f32_16x16x32_bf16(k00, qf[0], sa, 0, 0, 0); sa = __builtin_amdgcn_mfma_f32_16x16x32_bf16(k01, qf[1], sa, 0, 0, 0);
        sb = __builtin_amdgcn_mfma_f32_16x16x32_bf16(k10, qf[0], sb, 0, 0, 0); sb = __builtin_amdgcn_mfma_f32_16x16x32_bf16(k11, qf[1], sb, 0, 0, 0);
        if (DV == 5) { lrun += sa[0] + sb[0]; } else {
        const float lm = __builtin_fmaxf(__builtin_fmaxf(__builtin_fmaxf(sa[0], sa[1]), __builtin_fmaxf(sa[2], sa[3])), __builtin_fmaxf(__builtin_fmaxf(sb[0], sb[1]), __builtin_fmaxf(sb[2], sb[3])));
        if (__any(lm > mref + THR)) {
            float rm = __builtin_fmaxf(lm, __shfl_xor(lm, 16)); rm = __builtin_fmaxf(rm, __shfl_xor(rm, 32));
            const float mnew = __builtin_fmaxf(mref, rm), alpha = __builtin_amdgcn_exp2f(mref - mnew);
            lrun *= alpha;
#pragma unroll
            for (int d = 0; d < 4; ++d) oacc[d] = oacc[d] * alpha;
            mref = mnew;
        }
        float ls = 0.f;
#pragma unroll
        for (int e = 0; e < 4; ++e) { sa[e] = __builtin_amdgcn_exp2f(sa[e] - mref); sb[e] = __builtin_amdgcn_exp2f(sb[e] - mref); ls += sa[e] + sb[e]; }
        lrun += ls;
        u32x4 pw; pw.x = cvtpk(sa[0], sa[1]); pw.y = cvtpk(sa[2], sa[3]); pw.z = cvtpk(sb[0], sb[1]); pw.w = cvtpk(sb[2], sb[3]);
        const bf16x8 pk = __builtin_bit_cast(bf16x8, pw);
#pragma unroll
        for (int d = 0; d < 4; ++d) { const s16x4 lo = tr16(bufp + vro + d * 32), hi = tr16(bufp + vro + d * 32 + 16 * SH_PITCH);
            const bf16x8 va = __builtin_shufflevector(lo, hi, 0, 1, 2, 3, 4, 5, 6, 7);
            oacc[d] = __builtin_amdgcn_mfma_f32_16x16x32_bf16(va, pk, oacc[d], 0, 0, 0); }
        }
        if (DV != 4 && c + 1 < NSTEP) { LAS unsigned char* nb = sh + ((c + 1) & 1) * SH_BUF; *(LAS u32x4*)(nb + d0) = ga; if (two) *(LAS u32x4*)(nb + d1) = gb;
            ga = ha; gb = hb; const int cn = c + 3 < NSTEP ? c + 3 : NSTEP - 1; ha = ld(cn, r0); if (two) hb = ld(cn, r1); }
        if (DV != 4) asm volatile("s_waitcnt lgkmcnt(0)\n\ts_barrier" ::: "memory");
    }
}
template <bool SHARED, int DV>
__device__ __forceinline__ void item(LAS unsigned char* vst, const LAS float* ext, LAS unsigned char* sh, int wv, int b, int h, int blk, int r, const bf16_t* __restrict__ proj, bf16_t* __restrict__ O, int lane) {
    const int i16 = lane & 15, fq = lane >> 4, t0 = 256 * blk + r, vrow = lane >> 3, vch = lane & 7;
    const bf16_t* prow = proj + (size_t)b * SEQ * NPROJ;
    const int qpos = t0 + 16 * i16;
    const bf16_t* qp = prow + (size_t)qpos * NPROJ + COL_QA + 64 * h + 8 * fq;
    bf16x8 qf[2]; qf[0] = *(const bf16x8*)qp; qf[1] = *(const bf16x8*)(qp + 32);
    const unsigned kcol = (unsigned)(COL_KA + 64 * h + 8 * vch) * 2u, vcol = (unsigned)(COL_VA + 64 * h + 8 * vch) * 2u;
    LAS unsigned char* ktile = vst + 4096;
    LAS unsigned char* kw = ktile + vrow * 128 + ((vch ^ ((vrow >> 1) & 7)) * 16); LAS unsigned char* kwx = ktile + vrow * 128 + ((vch ^ ((vrow >> 1) & 7) ^ 4) * 16);
    const LAS unsigned char* kr = ktile + i16 * 128 + ((fq ^ ((i16 >> 1) & 7)) * 16); const LAS unsigned char* krx = ktile + i16 * 128 + (((fq + 4) ^ ((i16 >> 1) & 7)) * 16);
    LAS unsigned char* vw = vst + (vch >> 1) * 1024 + ((vrow ^ (vch >> 1)) * 32) + (vch & 1) * 16;
    const LAS unsigned char* vr[4];
#pragma unroll
    for (int d = 0; d < 4; ++d) vr[d] = vst + d * 1024 + (4 * fq + ((i16 >> 2) ^ d)) * 32 + (i16 & 3) * 8;
    f32x4 oacc[4];
#pragma unroll
    for (int d = 0; d < 4; ++d) oacc[d] = (f32x4){0.f, 0.f, 0.f, 0.f};
    float mref = -1.0e30f, lrun = 0.f;
    const LAS float* ext_h = ext + h * EXT_H;
    if (DV == 0 || DV == 1) Pat<4>::run<5>(kw, kwx, kr, krx, vw, vr, ext_h, prow, t0, lane, kcol, vcol, qf, oacc, mref, lrun);
    if (DV == 0 || DV == 1) Pat<2>::run<6>(kw, kwx, kr, krx, vw, vr, ext_h, prow, t0, lane, kcol, vcol, qf, oacc, mref, lrun);
    if (DV == 1 || DV == 3) {} else if (SHARED) p1_shared<DV>(sh, ext_h, prow, h, t0 - wv, wv, lane, qf, oacc, mref, lrun);
    else Pat<0>::run<12>(kw, kwx, kr, krx, vw, vr, ext_h, prow, t0, lane, kcol, vcol, qf, oacc, mref, lrun);
    lrun = pg8::fq_sum(lrun);
    const float inv = 1.f / lrun;
    bf16_t* op = O + ((size_t)b * SEQ + qpos) * DM + 64 * h + 4 * fq;
#pragma unroll
    for (int d = 0; d < 4; ++d) { u32x2 w; w.x = cvtpk(oacc[d][0] * inv, oacc[d][1] * inv); w.y = cvtpk(oacc[d][2] * inv, oacc[d][3] * inv); *(u32x2*)(op + 16 * d) = w; }
}
}

namespace dil2 {
using dil::Frags; using dil::EXT_OFF1; using dil::EXT_OFF2; using dil::EXT_H; using dil::THR; using dil::ROWB;
constexpr int WTILE = 16384;
constexpr int SH_PITCH = 160, SH_ROWS = 48, SH_TILE = SH_ROWS * SH_PITCH, SH_BUF = 2 * SH_TILE;
struct St { bf16x8 q0, q1; f32x4 o0, o1, o2, o3; float mref, lrun; };
constexpr int T2_PAD = 16, T2_HP = 604 + T2_PAD;
constexpr int T2_OFF1 = 176, T2_OFFC = 428, T2_H = 604;
__device__ __forceinline__ void build_ext_all(LAS float* ext4, const float* __restrict__ rel_bias, int hpar) {
    for (int idx = threadIdx.x; idx < 4 * T2_H; idx += NTHREADS) { const int i = idx / T2_H, k = idx % T2_H, h = 2 * i + hpar; int d, j;
        if (k < T2_OFF1) { d = 16; j = k - 79; } else if (k < T2_OFFC) { d = 4; j = k - T2_OFF1 - 124; } else { d = 1; j = k - T2_OFFC - 79; }
        ext4[idx] = (j >= -64 && j <= 64) ? rel_bias[t5_bucket(d * j) * 8 + h] * LOG2E : -__builtin_inff(); }
}
__device__ __forceinline__ void build_ext_2(LAS float* ext, const float* __restrict__ rel_bias, int h0, int h1) {
    for (int idx = threadIdx.x; idx < 2 * T2_HP; idx += NTHREADS) { const int i = idx / T2_HP, k = idx % T2_HP - T2_PAD, h = i ? h1 : h0; int d = 1, j = 1000;
        if (k >= 0) { if (k < T2_OFF1) { d = 16; j = k - 79; } else if (k < T2_OFFC) { d = 4; j = k - T2_OFF1 - 124; } else { d = 1; j = k - T2_OFFC - 79; } }
        ext[idx] = (j >= -64 && j <= 64) ? rel_bias[t5_bucket(d * j) * 8 + h] * LOG2E : -__builtin_inff(); }
}
__device__ __forceinline__ void build_ext_h(LAS float* ext, const float* __restrict__ rel_bias, int h) {
    for (int k = threadIdx.x; k < EXT_H + 176; k += NTHREADS) { int d, j; if (k < EXT_OFF1) { d = 16; j = k - 79; } else if (k < EXT_OFF2) { d = 4; j = k - EXT_OFF1 - 124; } else if (k < EXT_H) { d = 1; j = k - EXT_OFF2 - 304; } else { d = 1; j = k - EXT_H - 79; }
        ext[k] = (j >= -64 && j <= 64) ? rel_bias[t5_bucket(d * j) * 8 + h] * LOG2E : -__builtin_inff(); }
}
__device__ __forceinline__ float lanemax8(const f32x4 a, const f32x4 b) { return __builtin_fmaxf(__builtin_fmaxf(__builtin_fmaxf(a[0], a[1]), __builtin_fmaxf(a[2], a[3])), __builtin_fmaxf(__builtin_fmaxf(b[0], b[1]), __builtin_fmaxf(b[2], b[3]))); }
__device__ __forceinline__ void refresh(St& s, float lm) {
    float rm = __builtin_fmaxf(lm, __shfl_xor(lm, 16)); rm = __builtin_fmaxf(rm, __shfl_xor(rm, 32));
    const float mnew = __builtin_fmaxf(s.mref, rm), alpha = __builtin_amdgcn_exp2f(s.mref - mnew);
    s.lrun *= alpha; s.o0 = s.o0 * alpha; s.o1 = s.o1 * alpha; s.o2 = s.o2 * alpha; s.o3 = s.o3 * alpha; s.mref = mnew;
}
#ifndef DIL2_EXP
#define DIL2_EXP(x) __builtin_amdgcn_exp2f(x)
#endif
__device__ __forceinline__ bf16x8 expsum(St& s, f32x4 sa, f32x4 sb) {
    float ls = 0.f;
#pragma unroll
    for (int e = 0; e < 4; ++e) { sa[e] = DIL2_EXP(sa[e] - s.mref); sb[e] = DIL2_EXP(sb[e] - s.mref); ls += sa[e] + sb[e]; }
    s.lrun += ls;
    u32x4 pw; pw.x = cvtpk(sa[0], sa[1]); pw.y = cvtpk(sa[2], sa[3]); pw.z = cvtpk(sb[0], sb[1]); pw.w = cvtpk(sb[2], sb[3]);
    return __builtin_bit_cast(bf16x8, pw);
}
__device__ __forceinline__ void maskrows(f32x4& sa, f32x4& sb, int lbase, int fq, int lmax) {
    const float NEG = -__builtin_inff();
#pragma unroll
    for (int e = 0; e < 4; ++e) { const int la = lbase + 4 * fq + e, lb2 = la + 16; if (la < 0 || la >= lmax) sa[e] = NEG; if (lb2 < 0 || lb2 >= lmax) sb[e] = NEG; }
}
#define MF16(a, b, c) __builtin_amdgcn_mfma_f32_16x16x32_bf16((a), (b), (c), 0, 0, 0)
#define VFR(p) __builtin_shufflevector(tr16(p), tr16((p) + VHI), 0, 1, 2, 3, 4, 5, 6, 7)
__device__ __forceinline__ void soft2(St& A, St& B, f32x4 sa0, f32x4 sb0, f32x4 sa1, f32x4 sb1, bf16x8& pkA, bf16x8& pkB) {
    const float lmA = lanemax8(sa0, sb0), lmB = lanemax8(sa1, sb1);
    if (__any((lmA > A.mref + THR) || (lmB > B.mref + THR))) { refresh(A, lmA); refresh(B, lmB); }
    pkA = expsum(A, sa0, sb0); pkB = expsum(B, sa1, sb1);
}
struct Addr { LAS unsigned char *kw, *kwx, *vw; const LAS unsigned char *kr, *krx, *vr0, *vr1, *vr2, *vr3; };
template <int LD, bool SHARE_ = (LD == 2)>
struct Pat2 {
    static constexpr int D = 1 << LD, QS = 16 >> LD, LMAX = SEQ >> LD, DB = 8 >> LD, REMB = (LD == 4) ? 8 : 0;
    static constexpr bool SHARE = SHARE_;
    static constexpr int SH = (LD == 2) ? 2 : 16;
    static __device__ __forceinline__ void load(Frags& fa, Frags& fb, const bf16_t* __restrict__ prow, int Lb, int rem, int c, unsigned offK, unsigned offV, int vrow, unsigned kcol, unsigned vcol) {
        const int lbase = Lb - 64 + 32 * c;
        constexpr size_t R8 = (size_t)(8 << LD) * ROWB;
        if (lbase >= 0 && lbase + DB + 31 < LMAX) {
            const char* ua = (const char*)prow + (size_t)((lbase << LD) + rem) * ROWB; const char* ub = ua + 8 * ROWB;
            fa.k0 = *(const u32x4*)(ua + offK); fa.k1 = *(const u32x4*)(ua + offK + R8); fa.k2 = *(const u32x4*)(ua + offK + 2 * R8); fa.k3 = *(const u32x4*)(ua + offK + 3 * R8);
            fa.v0 = *(const u32x4*)(ua + offV); fa.v1 = *(const u32x4*)(ua + offV + R8); fa.v2 = *(const u32x4*)(ua + offV + 2 * R8); fa.v3 = *(const u32x4*)(ua + offV + 3 * R8);
            if constexpr (!SHARE) {
            fb.k0 = *(const u32x4*)(ub + offK); fb.k1 = *(const u32x4*)(ub + offK + R8); fb.k2 = *(const u32x4*)(ub + offK + 2 * R8); fb.k3 = *(const u32x4*)(ub + offK + 3 * R8);
            fb.v0 = *(const u32x4*)(ub + offV); fb.v1 = *(const u32x4*)(ub + offV + R8); fb.v2 = *(const u32x4*)(ub + offV + 2 * R8); fb.v3 = *(const u32x4*)(ub + offV + 3 * R8); }
        } else {
            auto rowp = [&](int l, int rm) { l = l < 0 ? 0 : (l > LMAX - 1 ? LMAX - 1 : l); return (const char*)prow + (size_t)((l << LD) + rm) * ROWB; };
            { const char* r0 = rowp(lbase + vrow, rem); const char* r1 = rowp(lbase + vrow + 8, rem); const char* r2 = rowp(lbase + vrow + 16, rem); const char* r3 = rowp(lbase + vrow + 24, rem);
              fa.k0 = *(const u32x4*)(r0 + kcol); fa.k1 = *(const u32x4*)(r1 + kcol); fa.k2 = *(const u32x4*)(r2 + kcol); fa.k3 = *(const u32x4*)(r3 + kcol);
              fa.v0 = *(const u32x4*)(r0 + vcol); fa.v1 = *(const u32x4*)(r1 + vcol); fa.v2 = *(const u32x4*)(r2 + vcol); fa.v3 = *(const u32x4*)(r3 + vcol); }
            if constexpr (!SHARE) { const int lb = lbase + DB, rb = rem + REMB;
              const char* r0 = rowp(lb + vrow, rb); const char* r1 = rowp(lb + vrow + 8, rb); const char* r2 = rowp(lb + vrow + 16, rb); const char* r3 = rowp(lb + vrow + 24, rb);
              fb.k0 = *(const u32x4*)(r0 + kcol); fb.k1 = *(const u32x4*)(r1 + kcol); fb.k2 = *(const u32x4*)(r2 + kcol); fb.k3 = *(const u32x4*)(r3 + kcol);
              fb.v0 = *(const u32x4*)(r0 + vcol); fb.v1 = *(const u32x4*)(r1 + vcol); fb.v2 = *(const u32x4*)(r2 + vcol); fb.v3 = *(const u32x4*)(r3 + vcol); }
        }
    }
    static __device__ __forceinline__ void stage(const Frags& fa, const Frags& fb, const Addr& a) {
        constexpr int BO = 8192;
        *(LAS u32x4*)(a.kw) = fa.k0; *(LAS u32x4*)(a.kwx + 8 * 128) = fa.k1; *(LAS u32x4*)(a.kw + 16 * 128) = fa.k2; *(LAS u32x4*)(a.kwx + 24 * 128) = fa.k3;
        if constexpr (!SHARE) { *(LAS u32x4*)(a.kw + BO) = fb.k0; *(LAS u32x4*)(a.kwx + BO + 8 * 128) = fb.k1; *(LAS u32x4*)(a.kw + BO + 16 * 128) = fb.k2; *(LAS u32x4*)(a.kwx + BO + 24 * 128) = fb.k3; }
        *(LAS u32x4*)(a.vw) = fa.v0; *(LAS u32x4*)(a.vw + 8 * 32) = fa.v1; *(LAS u32x4*)(a.vw + 16 * 32) = fa.v2; *(LAS u32x4*)(a.vw + 24 * 32) = fa.v3;
        if constexpr (!SHARE) { *(LAS u32x4*)(a.vw + BO) = fb.v0; *(LAS u32x4*)(a.vw + BO + 8 * 32) = fb.v1; *(LAS u32x4*)(a.vw + BO + 16 * 32) = fb.v2; *(LAS u32x4*)(a.vw + BO + 24 * 32) = fb.v3; }
    }
    static __device__ __forceinline__ void core(const Addr& a, const LAS float* tb, int Lb, int c, int fq, St& A, St& B) {
        constexpr int BO = 8192, VHI = 512;
        const int lbase = Lb - 64 + 32 * c;
        const LAS float* t = tb + 32 * c;
        if constexpr (SHARE) {
            f32x4 sa0 = {t[0], t[1], t[2], t[3]}, sb0 = {t[16], t[17], t[18], t[19]}, sa1 = {t[0 - SH], t[1 - SH], t[2 - SH], t[3 - SH]}, sb1 = {t[16 - SH], t[17 - SH], t[18 - SH], t[19 - SH]};
            if (!(lbase >= 0 && lbase + 31 < LMAX)) { maskrows(sa0, sb0, lbase, fq, LMAX); maskrows(sa1, sb1, lbase, fq, LMAX); }
            { const bf16x8 k00 = *(const LAS bf16x8*)a.kr, k01 = *(const LAS bf16x8*)a.krx, k10 = *(const LAS bf16x8*)(a.kr + 16 * 128), k11 = *(const LAS bf16x8*)(a.krx + 16 * 128);
              sa0 = MF16(k00, A.q0, sa0); sa1 = MF16(k00, B.q0, sa1); sb0 = MF16(k10, A.q0, sb0); sb1 = MF16(k10, B.q0, sb1);
              sa0 = MF16(k01, A.q1, sa0); sa1 = MF16(k01, B.q1, sa1); sb0 = MF16(k11, A.q1, sb0); sb1 = MF16(k11, B.q1, sb1); }
            bf16x8 v0 = VFR(a.vr0), v1 = VFR(a.vr1), v2 = VFR(a.vr2), v3 = VFR(a.vr3);
            __builtin_amdgcn_sched_barrier(0);
            bf16x8 pkA, pkB; soft2(A, B, sa0, sb0, sa1, sb1, pkA, pkB);
            asm volatile("" : "+v"(v0), "+v"(v1), "+v"(v2), "+v"(v3));
            A.o0 = MF16(v0, pkA, A.o0); B.o0 = MF16(v0, pkB, B.o0); A.o1 = MF16(v1, pkA, A.o1); B.o1 = MF16(v1, pkB, B.o1);
            A.o2 = MF16(v2, pkA, A.o2); B.o2 = MF16(v2, pkB, B.o2); A.o3 = MF16(v3, pkA, A.o3); B.o3 = MF16(v3, pkB, B.o3);
            return;
        }
        f32x4 sa0 = {t[0], t[1], t[2], t[3]}, sb0 = {t[16], t[17], t[18], t[19]}, sa1 = sa0, sb1 = sb0;
        if (!(lbase >= 0 && lbase + DB + 31 < LMAX)) { maskrows(sa0, sb0, lbase, fq, LMAX); maskrows(sa1, sb1, lbase + DB, fq, LMAX); }
        { const bf16x8 k00 = *(const LAS bf16x8*)a.kr, k01 = *(const LAS bf16x8*)a.krx, k10 = *(const LAS bf16x8*)(a.kr + 16 * 128), k11 = *(const LAS bf16x8*)(a.krx + 16 * 128);
          const bf16x8 j00 = *(const LAS bf16x8*)(a.kr + BO), j01 = *(const LAS bf16x8*)(a.krx + BO), j10 = *(const LAS bf16x8*)(a.kr + BO + 16 * 128), j11 = *(const LAS bf16x8*)(a.krx + BO + 16 * 128);
          sa0 = MF16(k00, A.q0, sa0); sa1 = MF16(j00, B.q0, sa1); sb0 = MF16(k10, A.q0, sb0); sb1 = MF16(j10, B.q0, sb1);
          sa0 = MF16(k01, A.q1, sa0); sa1 = MF16(j01, B.q1, sa1); sb0 = MF16(k11, A.q1, sb0); sb1 = MF16(j11, B.q1, sb1); }
        bf16x8 va0 = VFR(a.vr0), vb0 = VFR(a.vr0 + BO), va1 = VFR(a.vr1), vb1 = VFR(a.vr1 + BO), va2 = VFR(a.vr2), vb2 = VFR(a.vr2 + BO), va3 = VFR(a.vr3), vb3 = VFR(a.vr3 + BO);
        __builtin_amdgcn_sched_barrier(0);
        bf16x8 pkA, pkB; soft2(A, B, sa0, sb0, sa1, sb1, pkA, pkB);
        asm volatile("" : "+v"(va0), "+v"(vb0), "+v"(va1), "+v"(vb1), "+v"(va2), "+v"(vb2), "+v"(va3), "+v"(vb3));
        A.o0 = MF16(va0, pkA, A.o0); B.o0 = MF16(vb0, pkB, B.o0); A.o1 = MF16(va1, pkA, A.o1); B.o1 = MF16(vb1, pkB, B.o1);
        A.o2 = MF16(va2, pkA, A.o2); B.o2 = MF16(vb2, pkB, B.o2); A.o3 = MF16(va3, pkA, A.o3); B.o3 = MF16(vb3, pkB, B.o3);
    }
    template <int NSTEP>
    static __device__ __forceinline__ void run(const Addr& a, const LAS float* ext_h, const bf16_t* __restrict__ prow, int t0, int lane, unsigned kcol, unsigned vcol, St& A, St& B) {
        const int i16 = lane & 15, fq = lane >> 4, vrow = lane >> 3;
        const int Lb = __builtin_amdgcn_readfirstlane(t0 >> LD), rem = __builtin_amdgcn_readfirstlane(t0 & (D - 1));
        const unsigned offK = (unsigned)(vrow << LD) * ROWB + kcol, offV = (unsigned)(vrow << LD) * ROWB + vcol;
        const LAS float* tb = ext_h + (LD == 4 ? 0 : T2_OFF1) + 15 * QS + 4 * fq - QS * i16;
        Frags fa, fb;
        load(fa, fb, prow, Lb, rem, 0, offK, offV, vrow, kcol, vcol);
#pragma unroll 1
        for (int c = 0; c < NSTEP; ++c) {
            stage(fa, fb, a);
            if (c + 1 < NSTEP) load(fa, fb, prow, Lb, rem, c + 1, offK, offV, vrow, kcol, vcol);
            core(a, tb, Lb, c, fq, A, B);
        }
    }
    template <int NSTEP, int OFFS>
    static __device__ __forceinline__ void run2pairs(const Addr& a, const LAS float* ext_h, const bf16_t* __restrict__ prow, int t0, int lane, unsigned kcol, unsigned vcol, St& A0, St& B0, St& A1, St& B1) {
        const int i16 = lane & 15, fq = lane >> 4, vrow = lane >> 3;
        const int Lb = __builtin_amdgcn_readfirstlane(t0 >> LD), rem = __builtin_amdgcn_readfirstlane(t0 & (D - 1));
        const unsigned offK = (unsigned)(vrow << LD) * ROWB + kcol, offV = (unsigned)(vrow << LD) * ROWB + vcol;
        const LAS float* tb = ext_h + (LD == 4 ? 0 : T2_OFF1) + 15 * QS + 4 * fq - QS * i16;
        Frags fa, fb;
        load(fa, fb, prow, Lb, rem, 0, offK, offV, vrow, kcol, vcol);
#pragma unroll 1
        for (int g = 0; g < NSTEP + OFFS; ++g) {
            stage(fa, fb, a);
            if (g + 1 < NSTEP + OFFS) load(fa, fb, prow, Lb, rem, g + 1, offK, offV, vrow, kcol, vcol);
            if (g < NSTEP) core(a, tb, Lb, g, fq, A0, B0);
            if (g >= OFFS) core(a, tb, Lb + 32 * OFFS, g - OFFS, fq, A1, B1);
        }
    }
};
__device__ __forceinline__ void p1_shared(LAS unsigned char* sh, const LAS float* ext_h, const bf16_t* __restrict__ prow, int h, int T, int w, int lane, St& A, St& B) {
    constexpr int NSTEP = 12, VHI = 16 * SH_PITCH;
    const int tid = threadIdx.x, i16 = lane & 15, fq = lane >> 4;
    const int r0 = tid >> 4, c0 = tid & 15; const bool two = tid < 256; const int r1 = 32 + r0;
    const unsigned col0 = (unsigned)((c0 < 8 ? COL_KA : COL_VA - 64) + 64 * h + 8 * c0) * 2u;
    const int d0 = (c0 < 8 ? 0 : SH_TILE) + r0 * SH_PITCH + (c0 & 7) * 16, d1 = d0 + 32 * SH_PITCH;
    auto ld = [&](int c, int row) { int p = T - 64 + 32 * c + row; p = p < 0 ? 0 : (p > SEQ - 1 ? SEQ - 1 : p); return *(const u32x4*)((const char*)prow + (size_t)p * ROWB + col0); };
    u32x4 ga = ld(0, r0), gb = (u32x4){0u, 0u, 0u, 0u}, ha, hb = (u32x4){0u, 0u, 0u, 0u}; if (two) gb = ld(0, r1);
    __syncthreads();
    *(LAS u32x4*)(sh + d0) = ga; if (two) *(LAS u32x4*)(sh + d1) = gb;
    ga = ld(1, r0); if (two) gb = ld(1, r1);
    ha = ld(2, r0); if (two) hb = ld(2, r1);
    const LAS float* tb = ext_h + EXT_OFF2 + 15 * 16 + 4 * fq - 16 * i16;
    const int kro = (w + i16) * SH_PITCH + fq * 16, vro = SH_TILE + (w + 4 * fq + (i16 >> 2)) * SH_PITCH + (i16 & 3) * 8;
    constexpr int BO = 8 * SH_PITCH;
    asm volatile("s_waitcnt lgkmcnt(0)\n\ts_barrier" ::: "memory");
#pragma unroll 1
    for (int c = 0; c < NSTEP; ++c) {
        const LAS unsigned char* bufp = sh + (c & 1) * SH_BUF;
        const int lbase = T + w - 64 + 32 * c;
        const LAS float* t = tb + 32 * c;
        f32x4 sa0 = {t[0], t[1], t[2], t[3]}, sb0 = {t[16], t[17], t[18], t[19]}, sa1 = sa0, sb1 = sb0;
        if (!(lbase >= 0 && lbase + 8 + 31 < SEQ)) { maskrows(sa0, sb0, lbase, fq, SEQ); maskrows(sa1, sb1, lbase + 8, fq, SEQ); }
        { const LAS unsigned char* kp = bufp + kro;
          const bf16x8 k00 = *(const LAS bf16x8*)kp, k01 = *(const LAS bf16x8*)(kp + 64), k10 = *(const LAS bf16x8*)(kp + 16 * SH_PITCH), k11 = *(const LAS bf16x8*)(kp + 16 * SH_PITCH + 64);
          const bf16x8 j00 = *(const LAS bf16x8*)(kp + BO), j01 = *(const LAS bf16x8*)(kp + BO + 64), j10 = *(const LAS bf16x8*)(kp + BO + 16 * SH_PITCH), j11 = *(const LAS bf16x8*)(kp + BO + 16 * SH_PITCH + 64);
          sa0 = MF16(k00, A.q0, sa0); sa1 = MF16(j00, B.q0, sa1); sb0 = MF16(k10, A.q0, sb0); sb1 = MF16(j10, B.q0, sb1);
          sa0 = MF16(k01, A.q1, sa0); sa1 = MF16(j01, B.q1, sa1); sb0 = MF16(k11, A.q1, sb0); sb1 = MF16(j11, B.q1, sb1); }
        bf16x8 pkA, pkB; soft2(A, B, sa0, sb0, sa1, sb1, pkA, pkB);
        { const LAS unsigned char* vp = bufp + vro;
          A.o0 = MF16(VFR(vp), pkA, A.o0); B.o0 = MF16(VFR(vp + BO), pkB, B.o0); A.o1 = MF16(VFR(vp + 32), pkA, A.o1); B.o1 = MF16(VFR(vp + BO + 32), pkB, B.o1);
          A.o2 = MF16(VFR(vp + 64), pkA, A.o2); B.o2 = MF16(VFR(vp + BO + 64), pkB, B.o2); A.o3 = MF16(VFR(vp + 96), pkA, A.o3); B.o3 = MF16(VFR(vp + BO + 96), pkB, B.o3); }
        if (c + 1 < NSTEP) { LAS unsigned char* nb = sh + ((c + 1) & 1) * SH_BUF; *(LAS u32x4*)(nb + d0) = ga; if (two) *(LAS u32x4*)(nb + d1) = gb;
            ga = ha; gb = hb; const int cn = c + 3 < NSTEP ? c + 3 : NSTEP - 1; ha = ld(cn, r0); if (two) hb = ld(cn, r1); }
        asm volatile("s_waitcnt lgkmcnt(0)\n\ts_barrier" ::: "memory");
    }
}
constexpr int XP = 272, X_M = 272 * XP, X_L = X_M + 1088, IMG_ROWS = 400, IMG_V = IMG_ROWS * SH_PITCH;
__device__ __forceinline__ void p1_consec(LAS unsigned char* lds, const LAS float* ext_h, const bf16_t* __restrict__ prow, int h, int T, int w, int lane, St& A, St& B) {
    constexpr int VHI = 16 * SH_PITCH, BO = 16 * SH_PITCH;
    const int tid = fresh_tid(), i16 = tid & 15, fq = (tid & 63) >> 4;
    (void)lane;
    const int c0 = tid & 15, rb = tid >> 4;
    const unsigned col0 = (unsigned)((c0 < 8 ? COL_KA : COL_VA - 64) + 64 * h + 8 * c0) * 2u;
    const int dbase = (c0 < 8 ? 0 : IMG_V) + rb * SH_PITCH + (c0 & 7) * 16;
    auto ld = [&](int k) { int p = T - 64 + rb + 32 * k; p = p < 0 ? 0 : (p > SEQ - 1 ? SEQ - 1 : p); return *(const u32x4*)((const char*)prow + (size_t)p * ROWB + col0); };
    u32x4 g0 = ld(0), g1 = ld(1), g2 = ld(2), g3 = ld(3), g4 = ld(4), g5 = ld(5), g6 = ld(6), g7 = ld(7), g8 = ld(8), g9 = ld(9), g10 = ld(10), g11 = ld(11), g12 = (u32x4){0u, 0u, 0u, 0u};
    if (tid < 256) g12 = ld(12);
    bf16x8 nq0, nq1, nq2, nq3;
    { const bf16_t* qp = prow + (size_t)(T + 32 * w + i16) * NPROJ + COL_QA + 64 * h + 8 * fq;
      nq0 = *(const bf16x8*)qp; nq1 = *(const bf16x8*)(qp + 32); nq2 = *(const bf16x8*)(qp + 16 * NPROJ); nq3 = *(const bf16x8*)(qp + 16 * NPROJ + 32); }
    __syncthreads();
    {
        LAS unsigned char* xa = lds + (w * 17 + i16) * XP + fq * 16; LAS unsigned char* xb = lds + ((w + 8) * 17 + i16) * XP + fq * 16;
        *(LAS f32x4*)(xa) = A.o0; *(LAS f32x4*)(xa + 64) = A.o1; *(LAS f32x4*)(xa + 128) = A.o2; *(LAS f32x4*)(xa + 192) = A.o3;
        *(LAS f32x4*)(xb) = B.o0; *(LAS f32x4*)(xb + 64) = B.o1; *(LAS f32x4*)(xb + 128) = B.o2; *(LAS f32x4*)(xb + 192) = B.o3;
        LAS float* M = (LAS float*)(lds + X_M); LAS float* L = (LAS float*)(lds + X_L);
        const int sa = w * 17 + i16, sb = (w + 8) * 17 + i16;
        if (fq == 0) { M[sa] = A.mref; M[sb] = B.mref; }
        L[sa * 4 + fq] = A.lrun; L[sb * 4 + fq] = B.lrun;
    }
    asm volatile("s_waitcnt lgkmcnt(0)\n\ts_barrier" ::: "memory");
    {
        const int sa = i16 * 17 + 2 * w, sb = sa + 1;
        const LAS unsigned char* xa = lds + sa * XP + fq * 16; const LAS unsigned char* xb = lds + sb * XP + fq * 16;
        A.o0 = *(const LAS f32x4*)(xa); A.o1 = *(const LAS f32x4*)(xa + 64); A.o2 = *(const LAS f32x4*)(xa + 128); A.o3 = *(const LAS f32x4*)(xa + 192);
        B.o0 = *(const LAS f32x4*)(xb); B.o1 = *(const LAS f32x4*)(xb + 64); B.o2 = *(const LAS f32x4*)(xb + 128); B.o3 = *(const LAS f32x4*)(xb + 192);
        const LAS float* M = (const LAS float*)(lds + X_M); const LAS float* L = (const LAS float*)(lds + X_L);
        A.mref = M[sa]; B.mref = M[sb]; A.lrun = L[sa * 4 + fq]; B.lrun = L[sb * 4 + fq];
        A.q0 = nq0; A.q1 = nq1; B.q0 = nq2; B.q1 = nq3;
    }
    asm volatile("s_waitcnt lgkmcnt(0)\n\ts_barrier" ::: "memory");
    *(LAS u32x4*)(lds + dbase) = g0; *(LAS u32x4*)(lds + dbase + 32 * SH_PITCH) = g1; *(LAS u32x4*)(lds + dbase + 64 * SH_PITCH) = g2; *(LAS u32x4*)(lds + dbase + 96 * SH_PITCH) = g3;
    *(LAS u32x4*)(lds + dbase + 128 * SH_PITCH) = g4; *(LAS u32x4*)(lds + dbase + 160 * SH_PITCH) = g5; *(LAS u32x4*)(lds + dbase + 192 * SH_PITCH) = g6;
    *(LAS u32x4*)(lds + dbase + 224 * SH_PITCH) = g7; *(LAS u32x4*)(lds + dbase + 256 * SH_PITCH) = g8; *(LAS u32x4*)(lds + dbase + 288 * SH_PITCH) = g9; *(LAS u32x4*)(lds + dbase + 320 * SH_PITCH) = g10;
    *(LAS u32x4*)(lds + dbase + 352 * SH_PITCH) = g11; if (tid < 256) *(LAS u32x4*)(lds + dbase + 384 * SH_PITCH) = g12;
    asm volatile("s_waitcnt lgkmcnt(0)\n\ts_barrier" ::: "memory");
    const LAS float* tb = ext_h + T2_OFFC + 15 + 4 * fq - i16;
    const int kro = (32 * w + i16) * SH_PITCH + fq * 16, vro = IMG_V + (32 * w + 4 * fq + (i16 >> 2)) * SH_PITCH + (i16 & 3) * 8;
#pragma unroll 1
    for (int c = 0; c < 5; ++c) {
        const int lbase = T + 32 * w - 64 + 32 * c;
        const LAS float* t = tb + 32 * c;
        f32x4 sa0 = {t[0], t[1], t[2], t[3]}, sb0 = {t[16], t[17], t[18], t[19]}, sa1 = sa0, sb1 = sb0;
        if (!(lbase >= 0 && lbase + 16 + 31 < SEQ)) { maskrows(sa0, sb0, lbase, fq, SEQ); maskrows(sa1, sb1, lbase + 16, fq, SEQ); }
        { const LAS unsigned char* kp = lds + kro + 32 * c * SH_PITCH;
          const bf16x8 k00 = *(const LAS bf16x8*)kp, k01 = *(const LAS bf16x8*)(kp + 64), k10 = *(const LAS bf16x8*)(kp + 16 * SH_PITCH), k11 = *(const LAS bf16x8*)(kp + 16 * SH_PITCH + 64);
          const bf16x8 j10 = *(const LAS bf16x8*)(kp + 32 * SH_PITCH), j11 = *(const LAS bf16x8*)(kp + 32 * SH_PITCH + 64);
          sa0 = MF16(k00, A.q0, sa0); sa1 = MF16(k10, B.q0, sa1); sb0 = MF16(k10, A.q0, sb0); sb1 = MF16(j10, B.q0, sb1);
          sa0 = MF16(k01, A.q1, sa0); sa1 = MF16(k11, B.q1, sa1); sb0 = MF16(k11, A.q1, sb0); sb1 = MF16(j11, B.q1, sb1); }
        const LAS unsigned char* vp = lds + vro + 32 * c * SH_PITCH;
        bf16x8 va0 = VFR(vp), vb0 = VFR(vp + BO), va1 = VFR(vp + 32), vb1 = VFR(vp + BO + 32), va2 = VFR(vp + 64), vb2 = VFR(vp + BO + 64), va3 = VFR(vp + 96), vb3 = VFR(vp + BO + 96);
        __builtin_amdgcn_sched_barrier(0);
        bf16x8 pkA, pkB; soft2(A, B, sa0, sb0, sa1, sb1, pkA, pkB);
        asm volatile("" : "+v"(va0), "+v"(vb0), "+v"(va1), "+v"(vb1), "+v"(va2), "+v"(vb2), "+v"(va3), "+v"(vb3));
        A.o0 = MF16(va0, pkA, A.o0); B.o0 = MF16(vb0, pkB, B.o0); A.o1 = MF16(va1, pkA, A.o1); B.o1 = MF16(vb1, pkB, B.o1);
        A.o2 = MF16(va2, pkA, A.o2); B.o2 = MF16(vb2, pkB, B.o2); A.o3 = MF16(va3, pkA, A.o3); B.o3 = MF16(vb3, pkB, B.o3);
    }
    asm volatile("s_waitcnt lgkmcnt(0)\n\ts_barrier" ::: "memory");
}
__device__ __forceinline__ void store_item(const St& s, bf16_t* __restrict__ O, size_t row, int h, int fq) {
    const float l = pg8::fq_sum(s.lrun), inv = 1.f / l;
    bf16_t* op = O + row * DM + 64 * h + 4 * fq;
    u32x2 w; w.x = cvtpk(s.o0[0] * inv, s.o0[1] * inv); w.y = cvtpk(s.o0[2] * inv, s.o0[3] * inv); *(u32x2*)(op) = w;
    w.x = cvtpk(s.o1[0] * inv, s.o1[1] * inv); w.y = cvtpk(s.o1[2] * inv, s.o1[3] * inv); *(u32x2*)(op + 16) = w;
    w.x = cvtpk(s.o2[0] * inv, s.o2[1] * inv); w.y = cvtpk(s.o2[2] * inv, s.o2[3] * inv); *(u32x2*)(op + 32) = w;
    w.x = cvtpk(s.o3[0] * inv, s.o3[1] * inv); w.y = cvtpk(s.o3[2] * inv, s.o3[3] * inv); *(u32x2*)(op + 48) = w;
}
template <int DV>
__device__ __forceinline__ void round(LAS unsigned char* lds, const LAS float* ext_h, int b, int h, int blk, int w, const bf16_t* __restrict__ proj, bf16_t* __restrict__ O, int lane) {
    const int i16 = lane & 15, fq = lane >> 4, vrow = lane >> 3, vch = lane & 7, t0 = 256 * blk + w;
    const bf16_t* prow = proj + (size_t)b * SEQ * NPROJ;
    St A, B;
    { const bf16_t* qp = prow + (size_t)(t0 + 16 * i16) * NPROJ + COL_QA + 64 * h + 8 * fq;
      A.q0 = *(const bf16x8*)qp; A.q1 = *(const bf16x8*)(qp + 32); B.q0 = *(const bf16x8*)(qp + 8 * NPROJ); B.q1 = *(const bf16x8*)(qp + 8 * NPROJ + 32); }
    A.o0 = A.o1 = A.o2 = A.o3 = B.o0 = B.o1 = B.o2 = B.o3 = (f32x4){0.f, 0.f, 0.f, 0.f}; A.mref = B.mref = -1.0e30f; A.lrun = B.lrun = 0.f;
    const unsigned kcol = (unsigned)(COL_KA + 64 * h + 8 * vch) * 2u, vcol = (unsigned)(COL_VA + 64 * h + 8 * vch) * 2u;
    LAS unsigned char* vst = lds + w * WTILE; LAS unsigned char* ktile = vst + 4096;
    Addr a;
    a.kw = ktile + vrow * 128 + ((vch ^ ((vrow >> 1) & 7)) * 16); a.kwx = ktile + vrow * 128 + ((vch ^ ((vrow >> 1) & 7) ^ 4) * 16);
    a.kr = ktile + i16 * 128 + ((fq ^ ((i16 >> 1) & 7)) * 16); a.krx = ktile + i16 * 128 + (((fq + 4) ^ ((i16 >> 1) & 7)) * 16);
    a.vw = vst + (vch >> 1) * 1024 + ((vrow ^ (vch >> 1)) * 32) + (vch & 1) * 16;
    a.vr0 = vst + 0 * 1024 + (4 * fq + ((i16 >> 2) ^ 0)) * 32 + (i16 & 3) * 8; a.vr1 = vst + 1 * 1024 + (4 * fq + ((i16 >> 2) ^ 1)) * 32 + (i16 & 3) * 8;
    a.vr2 = vst + 2 * 1024 + (4 * fq + ((i16 >> 2) ^ 2)) * 32 + (i16 & 3) * 8; a.vr3 = vst + 3 * 1024 + (4 * fq + ((i16 >> 2) ^ 3)) * 32 + (i16 & 3) * 8;
    if (DV != 2) { Pat2<4>::run<5>(a, ext_h, prow, t0, lane, kcol, vcol, A, B);
    Pat2<2>::run<6>(a, ext_h, prow, t0, lane, kcol, vcol, A, B); }
    if (DV != 1) p1_consec(lds, ext_h, prow, h, 256 * blk, w, lane, A, B);
    store_item(A, O, (size_t)b * SEQ + 256 * blk + 32 * w + i16, h, fq);
    store_item(B, O, (size_t)b * SEQ + 256 * blk + 32 * w + 16 + i16, h, fq);
}
__device__ __forceinline__ void round2(LAS unsigned char* lds, const LAS float* ext_h, int b, int h, int P, int w, const bf16_t* __restrict__ proj, bf16_t* __restrict__ O, int lane) {
    const int i16 = lane & 15, fq = lane >> 4, vrow = lane >> 3, vch = lane & 7, blk0 = 2 * P, t0 = 256 * blk0 + w;
    const bf16_t* prow = proj + (size_t)b * SEQ * NPROJ;
    St S0, S1, S2, S3;
    { const bf16_t* qp = prow + (size_t)(t0 + 16 * i16) * NPROJ + COL_QA + 64 * h + 8 * fq;
      S0.q0 = *(const bf16x8*)qp; S0.q1 = *(const bf16x8*)(qp + 32); S2.q0 = *(const bf16x8*)(qp + 8 * NPROJ); S2.q1 = *(const bf16x8*)(qp + 8 * NPROJ + 32);
      const bf16_t* qn = qp + (size_t)256 * NPROJ;
      S1.q0 = *(const bf16x8*)qn; S1.q1 = *(const bf16x8*)(qn + 32); S3.q0 = *(const bf16x8*)(qn + 8 * NPROJ); S3.q1 = *(const bf16x8*)(qn + 8 * NPROJ + 32); }
    S0.o0 = S0.o1 = S0.o2 = S0.o3 = S1.o0 = S1.o1 = S1.o2 = S1.o3 = S2.o0 = S2.o1 = S2.o2 = S2.o3 = S3.o0 = S3.o1 = S3.o2 = S3.o3 = (f32x4){0.f, 0.f, 0.f, 0.f};
    S0.mref = S1.mref = S2.mref = S3.mref = -1.0e30f; S0.lrun = S1.lrun = S2.lrun = S3.lrun = 0.f;
    const unsigned kcol = (unsigned)(COL_KA + 64 * h + 8 * vch) * 2u, vcol = (unsigned)(COL_VA + 64 * h + 8 * vch) * 2u;
    LAS unsigned char* vst = lds + w * WTILE; LAS unsigned char* ktile = vst + 4096;
    Addr a;
    a.kw = ktile + vrow * 128 + ((vch ^ ((vrow >> 1) & 7)) * 16); a.kwx = ktile + vrow * 128 + ((vch ^ ((vrow >> 1) & 7) ^ 4) * 16);
    a.kr = ktile + i16 * 128 + ((fq ^ ((i16 >> 1) & 7)) * 16); a.krx = ktile + i16 * 128 + (((fq + 4) ^ ((i16 >> 1) & 7)) * 16);
    a.vw = vst + (vch >> 1) * 1024 + ((vrow ^ (vch >> 1)) * 32) + (vch & 1) * 16;
    a.vr0 = vst + 0 * 1024 + (4 * fq + ((i16 >> 2) ^ 0)) * 32 + (i16 & 3) * 8; a.vr1 = vst + 1 * 1024 + (4 * fq + ((i16 >> 2) ^ 1)) * 32 + (i16 & 3) * 8;
    a.vr2 = vst + 2 * 1024 + (4 * fq + ((i16 >> 2) ^ 2)) * 32 + (i16 & 3) * 8; a.vr3 = vst + 3 * 1024 + (4 * fq + ((i16 >> 2) ^ 3)) * 32 + (i16 & 3) * 8;
    Pat2<4, true>::run<5>(a, ext_h, prow, t0, lane, kcol, vcol, S0, S1);
    Pat2<4, true>::run<5>(a, ext_h, prow, t0 + 8, lane, kcol, vcol, S2, S3);
    Pat2<2>::run2pairs<6, 2>(a, ext_h, prow, t0, lane, kcol, vcol, S0, S2, S1, S3);
    p1_consec(lds, ext_h, prow, h, 256 * blk0, w, lane, S0, S2);
    store_item(S0, O, (size_t)b * SEQ + 256 * blk0 + 32 * w + i16, h, fq);
    store_item(S2, O, (size_t)b * SEQ + 256 * blk0 + 32 * w + 16 + i16, h, fq);
    p1_consec(lds, ext_h, prow, h, 256 * (blk0 + 1), w, lane, S1, S3);
    store_item(S1, O, (size_t)b * SEQ + 256 * (blk0 + 1) + 32 * w + i16, h, fq);
    store_item(S3, O, (size_t)b * SEQ + 256 * (blk0 + 1) + 32 * w + 16 + i16, h, fq);
}
#undef MF16
#undef VFR
}

__device__ __forceinline__ int rowmap(int n, int mode) {
    if (mode == 1) { if (n >= COL_KR) { const int c = n - COL_KR; return COL_KR + (c < 16 ? 2 * c : 2 * (c - 16) + 1); } return n; }
    if (mode == 2) { const int h = n / 96, w = n % 96; if (w >= 64) { const int c = w - 64; return 96 * h + 64 + (c < 16 ? 2 * c : 2 * (c - 16) + 1); } return n; }
    return n;
}
__device__ __forceinline__ void p0_transpose_item(const float* __restrict__ W, const float* __restrict__ g, int K, int N, bf16_t* __restrict__ WT, int mode, LAS float* scr, int item, int lane) {
    const int nblk = N / 32, kb = item / nblk, nb = item % nblk, k0 = 64 * kb, n0 = 32 * nb;
#pragma unroll
    for (int i = 0; i < 32; ++i) { const int kk = 2 * i + (lane >> 5); const float gv = g ? g[k0 + kk] : 1.f; scr[kk * 33 + (lane & 31)] = W[(size_t)(k0 + kk) * N + n0 + (lane & 31)] * gv; }
    asm volatile("s_waitcnt lgkmcnt(0)" ::: "memory");
    const int c = lane & 7;
#pragma unroll
    for (int j = 0; j < 4; ++j) { const int n = (lane >> 3) + 8 * j; const LAS float* s = scr + (8 * c) * 33 + n;
        u32x4 o; o.x = cvtpk(s[0 * 33], s[1 * 33]); o.y = cvtpk(s[2 * 33], s[3 * 33]); o.z = cvtpk(s[4 * 33], s[5 * 33]); o.w = cvtpk(s[6 * 33], s[7 * 33]);
        *(u32x4*)(WT + (size_t)rowmap(n0 + n, mode) * K + k0 + 8 * c) = o; }
    asm volatile("s_waitcnt lgkmcnt(0)" ::: "memory");
}

__device__ __forceinline__ void grid_barrier(unsigned* bar, unsigned G, unsigned& epoch) {
    asm volatile("s_waitcnt vmcnt(0)" ::: "memory");
    __syncthreads();
    if (threadIdx.x == 0) {
        __builtin_amdgcn_fence(__ATOMIC_RELEASE, "agent");
        asm volatile("s_waitcnt vmcnt(0)" ::: "memory");
        const unsigned target = (epoch + 1u) * G;
        __hip_atomic_fetch_add(bar, 1u, __ATOMIC_RELAXED, __HIP_MEMORY_SCOPE_AGENT);
        unsigned spins = 0;
        while (__hip_atomic_load(bar, __ATOMIC_RELAXED, __HIP_MEMORY_SCOPE_AGENT) < target) { __builtin_amdgcn_s_sleep(2); if (++spins > (1u << 24)) break; }
        __builtin_amdgcn_fence(__ATOMIC_ACQUIRE, "agent");
        asm volatile("s_waitcnt vmcnt(0)" ::: "memory");
    }
    ++epoch;
    __syncthreads();
}

#define XB_TMO      128
#define XB_XCNT(j)  (256  + 64 * (j))
#define XB_XSUB(j)  (1280 + 64 * (j))
#define XB_XGEN(j)  (2304 + 64 * (j))
#define XB_TOP      3328
#define XB_TOPGEN   3392
#define XCD_BAR_WORDS 3456
#define XB_SPIN_CAP (1u << 18)
__device__ __forceinline__ unsigned xb_ld(unsigned* p)              { return __hip_atomic_load(p, __ATOMIC_RELAXED, __HIP_MEMORY_SCOPE_AGENT); }
__device__ __forceinline__ unsigned xb_add(unsigned* p, unsigned v) { return __hip_atomic_fetch_add(p, v, __ATOMIC_RELAXED, __HIP_MEMORY_SCOPE_AGENT); }
__device__ __forceinline__ unsigned xb_xcc_id() { return (unsigned)__builtin_amdgcn_s_getreg((3 << 11) | 20) & 0xFu; }
#define XB_SPIN(cond, bar) do { unsigned _sp = 0; while (cond) { __builtin_amdgcn_s_sleep(1); \
    if ((++_sp & 255u) == 0u) { if (xb_ld(&(bar)[XB_TMO])) break; if (_sp > XB_SPIN_CAP) { atomicAdd(&(bar)[XB_TMO], 1u); break; } } } } while (0)
struct XcdBarrier { unsigned* bar; unsigned x; volatile LAS unsigned* st; };
__device__ __forceinline__ XcdBarrier xcd_barrier_post(unsigned* bar, volatile LAS unsigned* st) {
    XcdBarrier b; b.bar = bar; b.x = xb_xcc_id(); b.st = st;
    if (threadIdx.x == 0) (void)xb_add(&bar[XB_XCNT(b.x)], 1u);
    return b;
}
__device__ __forceinline__ void xcd_barrier_complete(unsigned* bar, unsigned x, unsigned& nloc, unsigned& nx) {
    const unsigned G = gridDim.x;
    unsigned sum, cnt, mine, sp = 0u;
    for (;;) {
        sum = 0u; cnt = 0u; mine = 0u;
#pragma unroll
        for (unsigned j = 0; j < 16; ++j) { const unsigned c = xb_ld(&bar[XB_XCNT(j)]); sum += c; cnt += (c > 0u) ? 1u : 0u; mine = (j == x) ? c : mine; }
        if (sum == G) break;
        __builtin_amdgcn_s_sleep(1);
        if ((++sp & 255u) == 0u) { if (xb_ld(&bar[XB_TMO])) break; if (sp > XB_SPIN_CAP) { atomicAdd(&bar[XB_TMO], 1u); break; } }
    }
    nloc = mine > 0u ? mine : 1u; nx = cnt > 0u ? cnt : 1u;
}
__device__ __forceinline__ void xcd_barrier(const XcdBarrier& b) {
    asm volatile("s_waitcnt vmcnt(0)" ::: "memory");
    __syncthreads();
    if (threadIdx.x == 0) {
        unsigned* bar = b.bar;
        __builtin_amdgcn_s_waitcnt(0);
        unsigned nloc = b.st[0], nx = b.st[1];
        if (nloc == 0u) { xcd_barrier_complete(bar, b.x, nloc, nx); b.st[0] = nloc; b.st[1] = nx; }
        const unsigned old = xb_add(&bar[XB_XSUB(b.x)], 1u);
        const unsigned gen = old / nloc;
        if (old + 1u == (gen + 1u) * nloc) {
            __builtin_amdgcn_fence(__ATOMIC_RELEASE, "agent");
            asm volatile("s_waitcnt vmcnt(0)" ::: "memory");
            const unsigned og = xb_add(&bar[XB_TOP], 1u);
            const unsigned tg = og / nx;
            if (og + 1u == (tg + 1u) * nx) xb_add(&bar[XB_TOPGEN], 1u);
            else XB_SPIN(xb_ld(&bar[XB_TOPGEN]) == tg, bar);
            __builtin_amdgcn_fence(__ATOMIC_ACQUIRE, "agent");
            xb_add(&bar[XB_XGEN(b.x)], 1u);
            asm volatile("s_waitcnt vmcnt(0)" ::: "memory");
        } else {
            XB_SPIN(xb_ld(&bar[XB_XGEN(b.x)]) == gen, bar);
            __builtin_amdgcn_fence(__ATOMIC_ACQUIRE, "agent");
            asm volatile("s_waitcnt vmcnt(0)" ::: "memory");
        }
    }
    __syncthreads();
}

__device__ __forceinline__ void transpose_item64(const float* __restrict__ W, const float* __restrict__ g, int K, int N, bf16_t* __restrict__ WT, int MODE, LAS unsigned* scr, int item, int lane) {
    const int nblk = (N + 63) / 64, kb = item / nblk, nb = item % nblk, k0 = 64 * kb, n0 = 64 * nb;
    const int nq = lane & 15, kq = lane >> 4;
    f32x4 a[8], b[8];
#pragma unroll
    for (int j = 0; j < 8; ++j) { const int nn = (n0 + 4 * nq < N) ? n0 + 4 * nq : N - 4;
        const float* p = W + (size_t)(k0 + 2 * (4 * j + kq)) * N + nn; a[j] = __builtin_nontemporal_load((const f32x4*)p); b[j] = __builtin_nontemporal_load((const f32x4*)(p + N)); }
#pragma unroll
    for (int j = 0; j < 8; ++j) { const int kp = 4 * j + kq; float g0 = 1.f, g1 = 1.f; if (g) { g0 = g[k0 + 2 * kp]; g1 = g[k0 + 2 * kp + 1]; }
#pragma unroll
        for (int i = 0; i < 4; ++i) scr[(4 * nq + i) * 33 + kp] = cvtpk(a[j][i] * g0, b[j][i] * g1); }
    asm volatile("s_waitcnt lgkmcnt(0)" ::: "memory");
    const int c = lane & 7;
#pragma unroll
    for (int j = 0; j < 8; ++j) { const int n = (lane >> 3) + 8 * j; const LAS unsigned* sp = scr + n * 33 + 4 * c;
        u32x4 o; o.x = sp[0]; o.y = sp[1]; o.z = sp[2]; o.w = sp[3];
        if (n0 + n < N) *(u32x4*)(WT + (size_t)rowmap(n0 + n, MODE) * K + k0 + 8 * c) = o; }
    asm volatile("s_waitcnt lgkmcnt(0)" ::: "memory");
}

struct Args { const float* in[13]; float* out; unsigned char* ws; int ph_lo, ph_hi; int flags; int pad; };

__global__ void __launch_bounds__(NTHREADS, 2) mega(Args args) {
    extern __shared__ __attribute__((aligned(16))) unsigned char lds_raw[];
    LAS unsigned char* lds = (LAS unsigned char*)lds_raw;
    const int wid = __builtin_amdgcn_readfirstlane((int)threadIdx.x >> 6);
    const int G = gridDim.x, bx = blockIdx.x;
    const int vcu = (G % 8 == 0) ? (bx % 8) * (G / 8) + bx / 8 : bx;
    const int gw = vcu * NWAVES + wid, NGW = G * NWAVES;
    unsigned char* ws = args.ws;
    const float* x = args.in[0]; float* out = args.out;
    float* ssq_q = (float*)(ws + WS_SSQ_Q); float* ssq_kv = (float*)(ws + WS_SSQ_KV); float* ssq_h1 = (float*)(ws + WS_SSQ_H1); float* ssq_h2 = (float*)(ws + WS_SSQ_H2);
    float2* rope = (float2*)(ws + WS_ROPE); float* xrs = (float*)(ws + WS_XRS);
    bf16_t* Wt_in = (bf16_t*)(ws + WS_WIN); bf16_t* Wt_qb = (bf16_t*)(ws + WS_WQB); bf16_t* Wt_kvb = (bf16_t*)(ws + WS_WKVB);
    bf16_t* Wt_out = (bf16_t*)(ws + WS_WOUT); bf16_t* Wt_up = (bf16_t*)(ws + WS_WUP); bf16_t* Wt_down = (bf16_t*)(ws + WS_WDOWN);
    bf16_t* xn = (bf16_t*)(ws + WS_XN); bf16_t* o = (bf16_t*)(ws + WS_O); bf16_t* proj = (bf16_t*)(ws + WS_PROJ);
    bf16_t* qb = (bf16_t*)(ws + WS_QB); bf16_t* kvb = (bf16_t*)(ws + WS_KVB); bf16_t* kpe = (bf16_t*)(ws + WS_KPE);
    bf16_t* h1b = (bf16_t*)(ws + WS_H1B); bf16_t* act = (bf16_t*)(ws + WS_ACT);
    const int lo = args.ph_lo, hi = args.ph_hi;
#define IN(k) (lo <= (k) && (k) < hi)
    volatile LAS unsigned* bst = (volatile LAS unsigned*)(lds + LDS_BYTES - 64);
    XcdBarrier xbar; xbar.bar = (unsigned*)(ws + WS_CTL + 512 * 1024); xbar.x = 0; xbar.st = bst;
    if (hi - lo > 1) {
        { u32x4* z = (u32x4*)(ws + WS_CTL); for (int i = bx * NTHREADS + (int)threadIdx.x; i < (int)(CTL_BYTES / 16); i += G * NTHREADS) if (i < 32768 || i >= 33792) z[i] = (u32x4){0u, 0u, 0u, 0u}; }
        if (args.flags < 0) cg::this_grid().sync();
        if (threadIdx.x < 2) bst[threadIdx.x] = 0u;
        __syncthreads();
        xbar = xcd_barrier_post((unsigned*)(ws + WS_CTL + 512 * 1024), bst);
    }
#define SEAM(k) do { if (IN(k) && IN((k) + 1)) xcd_barrier(xbar); } while (0)

    if (IN(0)) {
        const int tid = fresh_tid(), lane = tid & 63;
        LAS float* scr = (LAS float*)(lds + wid * 16384);
        constexpr int I_IN = (DM / 64) * ((NPROJ_REAL + 63) / 64), I_QB = (256 / 64) * (NQB / 64), I_KVB = (128 / 64) * (NKVB / 64);
        constexpr int NITEMS = I_IN + I_QB + I_KVB;
#pragma unroll 1
        for (int it = gw; it < NITEMS; it += NGW) {
            int r = it; const float* W = args.in[2]; const float* gn = args.in[1]; int K = DM, N = NPROJ_REAL, mode = 1; bf16_t* WT = Wt_in;
            if (r >= I_IN) { r -= I_IN; W = args.in[4]; gn = args.in[3]; K = 256; N = NQB; mode = 2; WT = Wt_qb;
                if (r >= I_QB) { r -= I_QB; W = args.in[6]; gn = args.in[5]; K = 128; N = NKVB; mode = 0; WT = Wt_kvb; } }
            transpose_item64(W, gn, K, N, WT, mode, (LAS unsigned*)scr, r, lane);
        }
        { u32x4* z = (u32x4*)(Wt_in + (size_t)NPROJ_REAL * DM); const int nz = (NPROJ - NPROJ_REAL) * DM * 2 / 16;
          for (int i = bx * NTHREADS + tid; i < nz; i += G * NTHREADS) z[i] = (u32x4){0u, 0u, 0u, 0u}; }
        for (int idx = bx * NTHREADS + tid; idx < SEQ * 16; idx += G * NTHREADS) { const int t = idx >> 4, j = idx & 15;
            const float invf = powf(10000.0f, -(float)(2 * j) / 32.0f); const float ang = (float)t * invf; float s, c; sincosf(ang, &s, &c); rope[idx] = make_float2(c, s); }
        for (int m = gw; m < MTOK; m += 4 * NGW) {
            f32x4 v[4][4];
#pragma unroll
            for (int q = 0; q < 4; ++q) { const f32x4* xr = (const f32x4*)(x + (size_t)(m + q * NGW) * DM) + lane;
#pragma unroll
                for (int j = 0; j < 4; ++j) v[q][j] = __builtin_nontemporal_load(xr + 64 * j); }
#pragma unroll
            for (int q = 0; q < 4; ++q) { float s = 0.f;
#pragma unroll
                for (int j = 0; j < 4; ++j) s += pg8::sq4(v[q][j]);
                const float ms = wave_sum(s) * (1.f / DM) + EPS; const float rstd = rsqrtf(ms);
                if (lane == 0) xrs[m + q * NGW] = sqrtf(ms);
                u32x2* op = (u32x2*)(xn + (size_t)(m + q * NGW) * DM) + lane;
#pragma unroll
                for (int j = 0; j < 4; ++j) { u32x2 w; w.x = cvtpk(v[q][j][0] * rstd, v[q][j][1] * rstd); w.y = cvtpk(v[q][j][2] * rstd, v[q][j][3] * rstd); op[64 * j] = w; } }
        }
        __syncthreads();
    }
    SEAM(0);
    if (IN(1)) {
        pg8::Gemm g{xn, Wt_in, DM, DM, DM}; pg8::StaticOrder S; S.init(MTOK, NPROJ, G, bx);
        pg8::EpiProj E{proj, ssq_q, ssq_kv, kpe, rope};
        pg8::gemm_phase(lds, g, S, E);
    }
    SEAM(1);
    if (IN(2)) {
        { pg8::Gemm g{proj + COL_CQ, Wt_qb, NPROJ, 256, 256}; pg8::StaticOrder S; S.init(MTOK, NQB, G, bx); pg8::EpiQ E{qb, ssq_q, rope}; pg8::gemm_phase(lds, g, S, E); }
        { pg8::Gemm g{proj + COL_CKV, Wt_kvb, NPROJ, 128, 128}; pg8::StaticOrder S; S.init(MTOK, NKVB, G, (bx + G / 2) % G); pg8::EpiKV E{kvb, ssq_kv}; pg8::gemm_phase(lds, g, S, E); }
    }
    SEAM(2);
    if (IN(3)) {
        if (!(args.flags & 2)) {
#ifdef MLA_VARIANT
#define MLA_CALL do { if (args.flags & 16) mla::unit<MLA_VARIANT>(lds, bh >> 3, bh & 7, qblk, qb, kvb, kpe, o); else mla::unit<0>(lds, bh >> 3, bh & 7, qblk, qb, kvb, kpe, o); } while (0)
#else
#define MLA_CALL mla::unit<0>(lds, bh >> 3, bh & 7, qblk, qb, kvb, kpe, o)
#endif
            if (G == 256) { const int xcd = vcu >> 5, slot = vcu & 31;
                for (int i = 0; i < 4; ++i) { const int bh = xcd * 8 + i * 2 + (slot >> 4), qblk = slot & 15; MLA_CALL; } }
            else for (int u = vcu; u < BATCH * 8 * 16; u += G) { const int bh = u >> 4, qblk = u & 15; MLA_CALL; }
        }
        if (!(args.flags & 1)) {
            const int lane = fresh_tid() & 63;
            __syncthreads();
            if (G == 256) { const int b = vcu >> 5, slot = vcu & 31;
#ifdef DIL_VARIANT
                if (args.flags & 32) {
                    if (DIL_VARIANT == 11) { for (int i = 0; i < 4096; ++i) asm volatile("s_barrier" ::: "memory"); }
                    else if (DIL_VARIANT == 12) { float x = (float)lane; for (int i = 0; i < 4096; ++i) {
#pragma unroll
                        for (int j = 0; j < 64; ++j) x = __builtin_fmaf(x, 1.0000001f, 0.5f); asm volatile("" : "+v"(x)); }
                        if (x == 12345.f) o[0] = 1; }
                    else if (DIL_VARIANT == 13) { u32x4 v = (u32x4){(unsigned)lane, 1u, 2u, 3u}; LAS u32x4* p = (LAS u32x4*)(lds + wid * 4096 + lane * 16); LAS u32x4* q = (LAS u32x4*)(lds + ((wid + 1) & 7) * 4096 + lane * 16);
                        for (int i = 0; i < 4096; ++i) { *p = v; asm volatile("s_waitcnt lgkmcnt(0)\n\ts_barrier" ::: "memory"); v = *q; asm volatile("s_waitcnt lgkmcnt(0)\n\ts_barrier" ::: "memory"); }
                        if (v.x == 0x12345678u) o[0] = 1; }
                } else
#endif
                { LAS float* ext2 = (LAS float*)(lds + 131072); const int hq = slot & 3;
                  dil2::build_ext_2(ext2, args.in[11], hq, hq + 4); __syncthreads();
                  for (int i = 0; i < 2; ++i) dil2::round2(lds, ext2 + dil2::T2_PAD + i * dil2::T2_HP, b, hq + 4 * i, slot >> 2, wid, proj, o, lane); } }
            else {
                LAS float* ext = (LAS float*)(lds + 65536);
                dil::build_ext(ext, args.in[11]);
                __syncthreads();
                LAS unsigned char* vst = lds + wid * 8192;
                for (int it = gw * 8; it < BATCH * 8 * 16 * 16; it += NGW * 8)
                    for (int k = 0; k < 8; ++k) { const int id = it + k; const int r = id & 15, blk = (id >> 4) & 15, h = (id >> 8) & 7, b = id >> 11; dil::item<false, 0>(vst, ext, lds + 102400, 0, b, h, blk, r, proj, o, lane); }
            }
            __syncthreads();
        }
        { const int lane = fresh_tid() & 63;
          unsigned* qctr = (unsigned*)(ws + WS_CTL + 700 * 1024);
          constexpr int L_OUT = (DM / 64) * (DM / 64), L_UP = (DM / 64) * (DFF / 64), L_DN = (DFF / 64) * (DM / 64);
          LAS unsigned* scr2 = (LAS unsigned*)(lds + wid * 16384);
          LAS unsigned* qs = (LAS unsigned*)(lds + 131072);
          for (;;) {
              __syncthreads();
              if (threadIdx.x == 0) qs[0] = __hip_atomic_fetch_add(qctr, 1u, __ATOMIC_RELAXED, __HIP_MEMORY_SCOPE_AGENT);
              __syncthreads();
              const int chunk = __builtin_amdgcn_readfirstlane((int)qs[0]);
              if (chunk * 8 >= L_OUT + L_UP + L_DN) break;
#pragma unroll 1
              for (int k = 0; k < 1; ++k) { int r = chunk * 8 + wid + k;
                  if (r < L_OUT) { transpose_item64(args.in[7], nullptr, DM, DM, Wt_out, 0, scr2, r, lane); continue; } r -= L_OUT;
                  if (r < L_UP) { transpose_item64(args.in[9], args.in[8], DM, DFF, Wt_up, 0, scr2, r, lane); continue; } r -= L_UP;
                  transpose_item64(args.in[10], nullptr, DFF, DM, Wt_down, 0, scr2, r, lane); }
          }
          __syncthreads(); }
    }
    SEAM(3);
    if (IN(4)) {
        pg8::Gemm g{o, Wt_out, DM, DM, DM}; pg8::StaticOrder S; S.init(MTOK, DM, G, bx);
        pg8::EpiOut E{xn, xrs, h1b, ssq_h1};
        pg8::gemm_phase(lds, g, S, E);
    }
    SEAM(4);
    if (IN(5)) {
        pg8::Gemm g{h1b, Wt_up, DM, DM, DM}; pg8::StaticOrder S; S.init(MTOK, DFF, G, bx);
        pg8::EpiUp E{act, ssq_h1};
        pg8::gemm_phase(lds, g, S, E);
    }
    SEAM(5);
    const bool fuse_final = (G == 256);
    if (IN(6)) {
        pg8::Gemm g{act, Wt_down, DFF, DFF, DFF}; pg8::StaticOrder S; S.init(MTOK, DM, G, bx);
        if (fuse_final) { pg8::EpiDownFused E{h1b, out, args.in[12], (float*)(ws + WS_XBUF), (unsigned*)(ws + WS_CTL + 576 * 1024), lds + pg8::STAGE_BYTES}; pg8::gemm_phase(lds, g, S, E); }
        else { pg8::EpiDown E{h1b, out, ssq_h2}; pg8::gemm_phase(lds, g, S, E); }
    }
    if (!fuse_final) {
    SEAM(6);
    if (IN(7)) {
        const int lane = fresh_tid() & 63;
        const f32x4* gr = (const f32x4*)args.in[12] + lane; f32x4 gg[4];
#pragma unroll
        for (int j = 0; j < 4; ++j) gg[j] = gr[64 * j];
        for (int m = gw; m < MTOK; m += NGW) {
            const float r = rsqrtf(ssq_h2[m] * (1.f / DM) + EPS);
            f32x4* xr = (f32x4*)(out + (size_t)m * DM) + lane;
#pragma unroll
            for (int j = 0; j < 4; ++j) xr[64 * j] = xr[64 * j] * gg[j] * r;
        }
    }
    }
#undef IN
#undef SEAM
}

extern "C" void kernel_launch(void* const* d_in, const int* in_sizes, int n_in, void* d_out, int out_size, void* d_ws, size_t ws_size, hipStream_t stream) {
    if (ws_size < WS_END || n_in < 13) { fprintf(stderr, "kernel_launch: workspace too small (%zu) or inputs missing (%d)\n", ws_size, n_in); return; }
    static int grid = 0;
    if (grid == 0) {
        int dev = 0, cus = 0, per_cu = 0;
        (void)hipGetDevice(&dev); (void)hipDeviceGetAttribute(&cus, hipDeviceAttributeMultiprocessorCount, dev);
        if (hipFuncSetAttribute((const void*)mega, hipFuncAttributeMaxDynamicSharedMemorySize, LDS_BYTES) != hipSuccess) { fprintf(stderr, "kernel_launch: hipFuncSetAttribute failed\n"); grid = -1; return; }
        if (hipOccupancyMaxActiveBlocksPerMultiprocessor(&per_cu, (const void*)mega, NTHREADS, LDS_BYTES) != hipSuccess || per_cu < 1) { fprintf(stderr, "kernel_launch: occupancy query failed (%d)\n", per_cu); per_cu = 1; }
        (void)hipGetLastError();
        grid = cus;
        if (grid <= 0) grid = 256;
    }
    if (grid < 0) return;
    unsigned char* ws = (unsigned char*)d_ws; float* out = (float*)d_out;
    (void)hipMemsetAsync(ws + WS_CTL + 512 * 1024, 0, 16 * 1024, stream);
    Args a{};
    for (int i = 0; i < 13; ++i) a.in[i] = (const float*)d_in[i];
    a.out = out; a.ws = ws;
    a.ph_lo = 0; a.ph_hi = 8; a.flags = 0;
    void* kargs[] = {&a};
    hipError_t e = hipLaunchCooperativeKernel((const void*)mega, dim3(grid), dim3(NTHREADS), kargs, LDS_BYTES, stream);
    if (e != hipSuccess) fprintf(stderr, "kernel_launch: cooperative launch failed: %s (grid %d)\n", hipGetErrorString(e), grid);
}
```
